# Optimizing an MI355X kernel written in HIP

```python
import jax
import jax.numpy as jnp
from jax import lax
import numpy as np

D_MODEL = 1024
BATCH = 8
SEQ = 4096
DEPTH = 2

HEAD_DIM = 64
H_NA = 4
H_DIL = 6
H_GQ = 6
H_GKV = 2
NA_W = H_NA * HEAD_DIM
DIL_W = H_DIL * HEAD_DIM
GQ_W = H_GQ * HEAD_DIM
GKV_W = H_GKV * HEAD_DIM
D_MIX = NA_W + DIL_W + GQ_W
D_IN = 3 * NA_W + 3 * DIL_W + GQ_W + 2 * GKV_W

GRID_W = 64
NA_KH_MAX = 8
NA_KW = 16
DIL_PATTERNS = ((128, 1), (512, 4), (2048, 16))
ROPE_THETA = 500000.0
ROPE_DIMS = HEAD_DIM // 4
AXIAL_THETA = 10000.0
Q_BLK = 128
D_FF = 2816
CONV_W = 3
EPS = 1e-6
NEG_INF = -1e30

kernel_name = 'hybrid_parallel_heads_encoder'


def rms_norm(x, g):
    xf = x.astype(jnp.float32)
    y = xf * lax.rsqrt(jnp.mean(xf * xf, axis=-1, keepdims=True) + EPS)
    return (y * g.astype(jnp.float32)).astype(x.dtype)


def rope_cos_sin(pos, dim, theta):
    inv = theta ** (-jnp.arange(0, dim, 2, dtype=jnp.float32) / dim)
    ang = pos.astype(jnp.float32)[:, None] * inv[None, :]
    return jnp.cos(ang), jnp.sin(ang)


def rotate(x, cos, sin):
    half = x.shape[-1] // 2
    x1 = x[..., :half].astype(jnp.float32)
    x2 = x[..., half:].astype(jnp.float32)
    c = cos[None, :, None, :]
    s = sin[None, :, None, :]
    return jnp.concatenate([x1 * c - x2 * s, x2 * c + x1 * s], axis=-1).astype(x.dtype)


def partial_rotary(x, cos, sin):
    return jnp.concatenate([rotate(x[..., :ROPE_DIMS], cos, sin), x[..., ROPE_DIMS:]], axis=-1)


def axial_rotary(x, cos_r, sin_r, cos_c, sin_c):
    half = x.shape[-1] // 2
    return jnp.concatenate([rotate(x[..., :half], cos_r, sin_r), rotate(x[..., half:], cos_c, sin_c)], axis=-1)


def neighbourhood_tables(S):
    rows = S // GRID_W
    kh = min(NA_KH_MAX, rows)
    t = jnp.arange(S)
    r = t // GRID_W
    c = t % GRID_W
    r0 = jnp.clip(r - kh // 2, 0, rows - kh)
    c0 = jnp.clip(c - NA_KW // 2, 0, GRID_W - NA_KW)
    kr = r0[:, None] + jnp.arange(kh)[None, :]
    kc = c0[:, None] + jnp.arange(NA_KW)[None, :]
    idx = (kr[:, :, None] * GRID_W + kc[:, None, :]).reshape(S, kh * NA_KW)
    dr = (kr - r[:, None] + NA_KH_MAX - 1)[:, :, None]
    dc = (kc - c[:, None] + NA_KW - 1)[:, None, :]
    return idx, dr, dc


def neighbourhood_attention(q, k, v, rpb, idx, dr, dc):
    B, S, H, hd = q.shape
    nk = idx.shape[1]
    nb = S // Q_BLK
    scale = hd ** -0.5
    bias = rpb[:, dr, dc].reshape(H, S, nk).astype(jnp.float32)
    qb = q.reshape(B, nb, Q_BLK, H, hd).transpose(1, 0, 2, 3, 4)
    idxb = idx.reshape(nb, Q_BLK, nk)
    biasb = bias.reshape(H, nb, Q_BLK, nk).transpose(1, 0, 2, 3)

    def block(args):
        qi, ii, bi = args
        kg = k[:, ii]
        vg = v[:, ii]
        s = jnp.einsum('bqhd,bqkhd->bhqk', qi, kg).astype(jnp.float32) * scale + bi[None]
        p = jax.nn.softmax(s, axis=-1).astype(v.dtype)
        return jnp.einsum('bhqk,bqkhd->bqhd', p, vg)

    o = lax.map(block, (qb, idxb, biasb))
    return o.transpose(1, 0, 2, 3, 4).reshape(B, S, H * hd)


def dilated_tables(S):
    t = jnp.arange(S)
    idxs, valids = [], []
    for w, d in DIL_PATTERNS:
        n = (w // 2) // d
        pos = t[:, None] + (jnp.arange(-n, n + 1) * d)[None, :]
        valids.append((pos >= 0) & (pos < S))
        idxs.append(jnp.clip(pos, 0, S - 1))
    return tuple(idxs), tuple(valids)


def dilated_window_attention(q, k, v, idxs, valids):
    B, S, H, hd = q.shape
    nb = S // Q_BLK
    scale = hd ** -0.5
    qb = q.reshape(B, nb, Q_BLK, H, hd).transpose(1, 0, 2, 3, 4)
    idxb = tuple(i.reshape(nb, Q_BLK, -1) for i in idxs)
    valb = tuple(m.reshape(nb, Q_BLK, -1) for m in valids)

    def block(args):
        qi, ii, mm = args
        lses, outs = [], []
        for ig, mg in zip(ii, mm):
            kg = k[:, ig]
            vg = v[:, ig]
            s = jnp.einsum('bqhd,bqkhd->bhqk', qi, kg).astype(jnp.float32) * scale
            s = jnp.where(mg[None, None], s, NEG_INF)
            lse = jax.nn.logsumexp(s, axis=-1)
            p = jnp.exp(s - lse[..., None]).astype(v.dtype)
            outs.append(jnp.einsum('bhqk,bqkhd->bqhd', p, vg))
            lses.append(lse)
        wts = jax.nn.softmax(jnp.stack(lses), axis=0).astype(v.dtype)
        return jnp.einsum('gbhq,gbqhd->bqhd', wts, jnp.stack(outs))

    o = lax.map(block, (qb, idxb, valb))
    return o.transpose(1, 0, 2, 3, 4).reshape(B, S, H * hd)


def gqa_block_attention(q, k, v):
    B, S, Hq, hd = q.shape
    Hkv = k.shape[2]
    g = Hq // Hkv
    nb = S // Q_BLK
    scale = hd ** -0.5
    qb = q.reshape(B, nb, Q_BLK, Hkv, g, hd).transpose(1, 0, 2, 3, 4, 5)

    def block(qi):
        s = jnp.einsum('bqkgd,bskd->bkgqs', qi, k).astype(jnp.float32) * scale
        p = jax.nn.softmax(s, axis=-1).astype(v.dtype)
        return jnp.einsum('bkgqs,bskd->bqkgd', p, v)

    o = lax.map(block, qb)
    return o.transpose(1, 0, 2, 3, 4, 5).reshape(B, S, Hq * hd)


def depthwise_conv_centred(z, w, b):
    S = z.shape[1]
    pad = CONV_W // 2
    zp = jnp.pad(z, ((0, 0), (pad, pad), (0, 0)))
    out = zp[:, 0:S] * w[0] + b
    for j in range(1, CONV_W):
        out = out + zp[:, j:j + S] * w[j]
    return out


def mixer_sublayer(x, n1, w_in_l, qg, kg, rpb_l, og, w_out_l, tables):
    (na_idx, na_dr, na_dc, dil_idx, dil_val, cos1, sin1, cos_r, sin_r, cos_c, sin_c) = tables
    B, S, _ = x.shape
    h = rms_norm(x, n1)
    proj = h @ w_in_l
    sizes = (NA_W, NA_W, NA_W, DIL_W, DIL_W, DIL_W, GQ_W, GKV_W, GKV_W)
    cuts = [int(c) for c in np.cumsum(sizes)[:-1]]
    qa, ka, va, qd, kd, vd, qc, kc, vc = jnp.split(proj, cuts, axis=-1)

    def heads(z, n):
        return z.reshape(B, S, n, HEAD_DIM)

    qa = rms_norm(heads(qa, H_NA), qg[0])
    ka = rms_norm(heads(ka, H_NA), kg[0])
    out_a = neighbourhood_attention(qa, ka, heads(va, H_NA), rpb_l, na_idx, na_dr, na_dc)
    qd = partial_rotary(rms_norm(heads(qd, H_DIL), qg[1]), cos1, sin1)
    kd = partial_rotary(rms_norm(heads(kd, H_DIL), kg[1]), cos1, sin1)
    out_d = dilated_window_attention(qd, kd, heads(vd, H_DIL), dil_idx, dil_val)
    qc = axial_rotary(rms_norm(heads(qc, H_GQ), qg[2]), cos_r, sin_r, cos_c, sin_c)
    kc = axial_rotary(rms_norm(heads(kc, H_GKV), kg[2]), cos_r, sin_r, cos_c, sin_c)
    out_c = gqa_block_attention(qc, kc, heads(vc, H_GKV))

    mix = jnp.concatenate([
        rms_norm(out_a, og[:NA_W]),
        rms_norm(out_d, og[NA_W:NA_W + DIL_W]),
        rms_norm(out_c, og[NA_W + DIL_W:]),
    ], axis=-1)
    return x + mix @ w_out_l


def channel_sublayer(x, n2, w_gu, cw, cb, w_dn):
    h = rms_norm(x, n2)
    g, u = jnp.split(h @ w_gu, 2, axis=-1)
    g = depthwise_conv_centred(g, cw, cb)
    return x + (jax.nn.gelu(g, approximate=False) * u) @ w_dn


def setup_inputs(seed: int = 0) -> dict:
    key = jax.random.key(seed)
    ks = jax.random.split(key, 13)

    def nrm(k, shape, s):
        return s * jax.random.normal(k, shape, jnp.float32)

    return {
        'x': nrm(ks[0], (BATCH, SEQ, D_MODEL), 1.0),
        'norm1_g': 1.0 + nrm(ks[1], (DEPTH, D_MODEL), 0.02),
        'w_in': nrm(ks[2], (DEPTH, D_MODEL, D_IN), D_MODEL ** -0.5),
        'q_norm_g': 1.0 + nrm(ks[3], (DEPTH, 3, HEAD_DIM), 0.02),
        'k_norm_g': 1.0 + nrm(ks[4], (DEPTH, 3, HEAD_DIM), 0.02),
        'rpb': nrm(ks[5], (DEPTH, H_NA, 2 * NA_KH_MAX - 1, 2 * NA_KW - 1), 0.1),
        'out_norm_g': 1.0 + nrm(ks[6], (DEPTH, D_MIX), 0.02),
        'w_out': nrm(ks[7], (DEPTH, D_MIX, D_MODEL), D_MIX ** -0.5),
        'norm2_g': 1.0 + nrm(ks[8], (DEPTH, D_MODEL), 0.02),
        'w_gate_up': nrm(ks[9], (DEPTH, D_MODEL, 2 * D_FF), D_MODEL ** -0.5),
        'conv_w': nrm(ks[10], (DEPTH, CONV_W, D_FF), CONV_W ** -0.5),
        'conv_b': nrm(ks[11], (DEPTH, D_FF), 0.02),
        'w_down': nrm(ks[12], (DEPTH, D_FF, D_MODEL), D_FF ** -0.5),
    }


def reference(x, norm1_g, w_in, q_norm_g, k_norm_g, rpb, out_norm_g, w_out, norm2_g, w_gate_up, conv_w, conv_b, w_down):
    S = x.shape[1]
    t = jnp.arange(S, dtype=jnp.int32)
    cos1, sin1 = rope_cos_sin(t, ROPE_DIMS, ROPE_THETA)
    cos_r, sin_r = rope_cos_sin(t // GRID_W, HEAD_DIM // 2, AXIAL_THETA)
    cos_c, sin_c = rope_cos_sin(t % GRID_W, HEAD_DIM // 2, AXIAL_THETA)
    na_idx, na_dr, na_dc = neighbourhood_tables(S)
    dil_idx, dil_val = dilated_tables(S)
    tables = (na_idx, na_dr, na_dc, dil_idx, dil_val, cos1, sin1, cos_r, sin_r, cos_c, sin_c)
    for l in range(DEPTH):
        x = mixer_sublayer(x, norm1_g[l], w_in[l], q_norm_g[l], k_norm_g[l], rpb[l],
                           out_norm_g[l], w_out[l], tables)
        x = channel_sublayer(x, norm2_g[l], w_gate_up[l], conv_w[l], conv_b[l], w_down[l])
    return x
```

```cpp
#ifndef DBG_FAST
#define DBG_FAST -1
#endif
#include <hip/hip_runtime.h>
#include <hip/hip_cooperative_groups.h>
#include <hip/hip_bf16.h>
#include <cmath>
#include <cstdint>
#include <cstdio>

typedef unsigned short bf16_t;
constexpr int BATCH = 8, SEQ = 4096, DM = 1024, M = BATCH * SEQ, DIN = 2560, DFF = 2816;
constexpr int OB_LD = 1792;
constexpr float EPS = 1e-6f;
constexpr float LOG2E = 1.4426950408889634f;
constexpr float C2 = 0.125f * LOG2E;
constexpr size_t MiB = 1u << 20;
constexpr size_t WS_CTL = 0, WS_TAB = 1 * MiB, WS_SSP = 2 * MiB, WS_LSE = 4 * MiB, WS_W = 8 * MiB, WS_XB = 57 * MiB, WS_PROJ = 122 * MiB, WS_OBUF = 282 * MiB,
                 WS_MIX = 122 * MiB, WS_ACT = 122 * MiB, WS_TMP = 394 * MiB;

typedef float f32x2v_t __attribute__((ext_vector_type(2)));
__device__ const double INV1[8] = {1.0, 0.19392274474868576, 0.03760603093086393, 0.0072926647372171085, 0.0014142135623730952, 0.0002742481756762073, 5.318295896944988e-05, 1.0313385377212458e-05};
__device__ const double INV2[16] = {1.0, 0.5623413251903491, 0.31622776601683794, 0.1778279410038923, 0.09999999999999999, 0.056234132519034905, 0.03162277660168379, 0.01778279410038923,
                                    0.01, 0.005623413251903491, 0.0031622776601683794, 0.0017782794100389228, 0.001, 0.000562341325190349, 0.00031622776601683794, 0.0001778279410038923};

__device__ __forceinline__ float bf2f(bf16_t b) { return __uint_as_float(((unsigned)b) << 16); }
__device__ __forceinline__ bf16_t f2bf(float f) { unsigned u = __float_as_uint(f); return (bf16_t)((u + 0x7fffu + ((u >> 16) & 1u)) >> 16); }
__device__ __forceinline__ float wave_sum(float v) {
#pragma unroll
    for (int o = 1; o < 64; o <<= 1) v += __shfl_xor(v, o);
    return v;
}
__device__ __forceinline__ float2 sincos_d(double a) {
    const double k = rint(a * 0.63661977236758134308);
    double r = fma(-k, 1.57079632679489655800, a); r = fma(-k, 6.12323399573676603587e-17, r);
    const double r2 = r * r;
    const double sp = r * (1 + r2 * (-1 / 6. + r2 * (1 / 120. + r2 * (-1 / 5040. + r2 * (1 / 362880. + r2 * (-1 / 39916800. + r2 * (1 / 6227020800.)))))));
    const double cp = 1 + r2 * (-0.5 + r2 * (1 / 24. + r2 * (-1 / 720. + r2 * (1 / 40320. + r2 * (-1 / 3628800. + r2 * (1 / 479001600. + r2 * (-1 / 87178291200.)))))));
    const int q = (int)((long long)k & 3);
    double c, s;
    if (q == 0) { c = cp; s = sp; } else if (q == 1) { c = -sp; s = cp; } else if (q == 2) { c = -cp; s = -sp; } else { c = sp; s = -cp; }
    return make_float2((float)c, (float)s);
}
__device__ __forceinline__ float row_rstd(const float* ssp, int row) {
    const float4* p = (const float4*)(ssp + (size_t)row * 16);
    const float4 a = p[0], b = p[1], c = p[2], d = p[3];
    const float s = ((a.x + a.y) + (a.z + a.w)) + ((b.x + b.y) + (b.z + b.w)) + ((c.x + c.y) + (c.z + c.w)) + ((d.x + d.y) + (d.z + d.w));
    return rsqrtf(s * (1.0f / DM) + EPS);
}

#if 1
__global__ void k_tables(float2* rot1, float2* rotax) {
    const int i = blockIdx.x * 256 + threadIdx.x;
    if (i < 4096 * 8) rot1[i] = sincos_d((double)(i >> 3) * INV1[i & 7]);
    if (i < 64 * 16) rotax[i] = sincos_d((double)(i >> 4) * INV2[i & 15]);
}
__global__ __launch_bounds__(256) void k_prep_x(const float* __restrict__ x, bf16_t* xb, float* ssp) {
    const int row = blockIdx.x * 4 + (threadIdx.x >> 6), lane = threadIdx.x & 63;
    const float4* xr = (const float4*)(x + (size_t)row * DM);
    float ss = 0.f;
#pragma unroll
    for (int j = 0; j < 4; ++j) {
        const float4 v = xr[lane + 64 * j]; ss += (v.x * v.x + v.y * v.y) + (v.z * v.z + v.w * v.w);
        uint2 o; o.x = (unsigned)f2bf(v.x) | ((unsigned)f2bf(v.y) << 16); o.y = (unsigned)f2bf(v.z) | ((unsigned)f2bf(v.w) << 16);
        *(uint2*)(xb + (size_t)row * DM + (lane + 64 * j) * 4) = o;
    }
    ss = wave_sum(ss);
    if (lane < 16) ssp[(size_t)row * 16 + lane] = lane == 0 ? ss : 0.f;
}
template <int MODE> __global__ __launch_bounds__(256) void k_ngemm(const bf16_t* __restrict__ A, int lda, const float* __restrict__ gk, const float* __restrict__ W, int N, int K,
                                                                    const float* ssp, float* C, int ldc, const float* res) {
    __shared__ float As[16][68], Bs[16][64];
    const int tid = threadIdx.x, tx = tid & 15, ty = tid >> 4, m0 = blockIdx.y * 64, n0 = blockIdx.x * 64;
    float acc[4][4];
#pragma unroll
    for (int i = 0; i < 4; ++i)
#pragma unroll
        for (int j = 0; j < 4; ++j) acc[i][j] = 0.f;
    for (int k0 = 0; k0 < K; k0 += 16) {
        { const int r = tid >> 2, kk = (tid & 3) * 4; const bf16_t* ap = A + (size_t)(m0 + r) * lda + k0 + kk;
#pragma unroll
          for (int e = 0; e < 4; ++e) As[kk + e][r] = bf2f(ap[e]) * (gk ? gk[k0 + kk + e] : 1.f); }
        { const int kk = tid >> 4, nn = (tid & 15) * 4; const float4 w = *(const float4*)(W + (size_t)(k0 + kk) * N + n0 + nn); *(float4*)&Bs[kk][nn] = w; }
        __syncthreads();
#pragma unroll
        for (int kk = 0; kk < 16; ++kk) {
            float a[4], b[4];
#pragma unroll
            for (int i = 0; i < 4; ++i) a[i] = As[kk][ty * 4 + i];
#pragma unroll
            for (int j = 0; j < 4; ++j) b[j] = Bs[kk][tx * 4 + j];
#pragma unroll
            for (int i = 0; i < 4; ++i)
#pragma unroll
                for (int j = 0; j < 4; ++j) acc[i][j] += a[i] * b[j];
        }
        __syncthreads();
    }
#pragma unroll
    for (int i = 0; i < 4; ++i) {
        const int row = m0 + ty * 4 + i; const float rs = (MODE == 0 && ssp) ? row_rstd(ssp, row) : 1.f;
#pragma unroll
        for (int j = 0; j < 4; ++j) { const size_t o = (size_t)row * ldc + n0 + tx * 4 + j; C[o] = (MODE == 0) ? acc[i][j] * rs : res[o] + acc[i][j]; }
    }
}
__global__ __launch_bounds__(256) void k_qkfix(const float* __restrict__ tmp, int row0, bf16_t* proj, const float* qg, const float* kg, const float2* rot1, const float2* rotax) {
    const int idx = blockIdx.x * 256 + threadIdx.x, r = idx / 40, hd = idx % 40, row = row0 + r, t = row % SEQ;
    const float* src = tmp + (size_t)r * DIN + hd * 64; bf16_t* dst = proj + (size_t)row * DIN + hd * 64;
    int mixer, isq, isv = 0;
    if (hd < 4) { mixer = 0; isq = 1; } else if (hd < 8) { mixer = 0; isq = 0; } else if (hd < 12) { mixer = 0; isq = 0; isv = 1; }
    else if (hd < 18) { mixer = 1; isq = 1; } else if (hd < 24) { mixer = 1; isq = 0; } else if (hd < 30) { mixer = 1; isq = 0; isv = 1; }
    else if (hd < 36) { mixer = 2; isq = 1; } else if (hd < 38) { mixer = 2; isq = 0; } else { mixer = 2; isq = 0; isv = 1; }
    if (isv) { for (int i = 0; i < 64; ++i) dst[i] = f2bf(src[i]); return; }
    float ss = 0.f; for (int i = 0; i < 64; ++i) ss += src[i] * src[i];
    const float rs = rsqrtf(ss * (1.f / 64.f) + EPS) ; const float sc = isq ? C2 : 1.f;
    const float* g = (isq ? qg : kg) + mixer * 64;
    if (mixer == 0) { for (int i = 0; i < 64; ++i) dst[i] = f2bf(src[i] * rs * g[i] * sc); }
    else if (mixer == 1) {
        for (int i = 0; i < 8; ++i) { const float2 cs = rot1[t * 8 + i]; const float a = src[i] * rs * g[i], b = src[i + 8] * rs * g[i + 8];
            dst[i] = f2bf((a * cs.x - b * cs.y) * sc); dst[i + 8] = f2bf((b * cs.x + a * cs.y) * sc); }
        for (int i = 16; i < 64; ++i) dst[i] = f2bf(src[i] * rs * g[i] * sc);
    } else {
        for (int i = 0; i < 16; ++i) {
            { const float2 cs = rotax[(t >> 6) * 16 + i]; const float a = src[i] * rs * g[i], b = src[i + 16] * rs * g[i + 16];
              dst[i] = f2bf((a * cs.x - b * cs.y) * sc); dst[i + 16] = f2bf((b * cs.x + a * cs.y) * sc); }
            { const float2 cs = rotax[(t & 63) * 16 + i]; const float a = src[32 + i] * rs * g[32 + i], b = src[48 + i] * rs * g[48 + i];
              dst[32 + i] = f2bf((a * cs.x - b * cs.y) * sc); dst[48 + i] = f2bf((b * cs.x + a * cs.y) * sc); }
        }
    }
}
template <int MODE> __global__ __launch_bounds__(256) void k_nattn(const bf16_t* __restrict__ proj, bf16_t* obuf, float* lse, const float* __restrict__ rpb, int pat) {
    const int row = blockIdx.x * 256 + threadIdx.x, h = blockIdx.y, b = row / SEQ, t = row % SEQ;
    const int qcol = MODE == 0 ? h * 64 : MODE == 1 ? 768 + h * 64 : 1920 + h * 64;
    const int kcol = MODE == 0 ? 256 + h * 64 : MODE == 1 ? 1152 + h * 64 : 2304 + (h / 3) * 64;
    const int vcol = MODE == 0 ? 512 + h * 64 : MODE == 1 ? 1536 + h * 64 : 2432 + (h / 3) * 64;
    const int ocol = MODE == 0 ? h * 64 : MODE == 1 ? (pat == 0 ? 256 : pat == 1 ? 1024 : 1408) + h * 64 : 640 + h * 64;
    float q[64], o[64];
    { const uint4* qp = (const uint4*)(proj + (size_t)row * DIN + qcol);
#pragma unroll
      for (int c = 0; c < 8; ++c) { const uint4 v = qp[c]; const unsigned w[4] = {v.x, v.y, v.z, v.w};
#pragma unroll
          for (int e = 0; e < 4; ++e) { q[c * 8 + 2 * e] = __uint_as_float(w[e] << 16); q[c * 8 + 2 * e + 1] = __uint_as_float(w[e] & 0xffff0000u); } } }
#pragma unroll
    for (int d = 0; d < 64; ++d) o[d] = 0.f;
    float m = -1e30f, l = 0.f;
    const int nk = MODE == 0 ? 128 : MODE == 1 ? 129 : SEQ;
    const int dil = pat == 0 ? 1 : pat == 1 ? 4 : 16;
    const int gr = t >> 6, gc = t & 63;
    const int r0 = min(max(gr - 4, 0), 56), c0 = min(max(gc - 8, 0), 48);
    for (int j = 0; j < nk; ++j) {
        int tok; float bias = 0.f;
        if (MODE == 0) { const int kr = r0 + (j >> 4), kc = c0 + (j & 15); tok = kr * 64 + kc; bias = rpb[(h * 15 + (kr - gr + 7)) * 31 + (kc - gc + 15)] * LOG2E; }
        else if (MODE == 1) { tok = t + (j - 64) * dil; if (tok < 0 || tok >= SEQ) continue; }
        else tok = j;
        const uint4* kp = (const uint4*)(proj + (size_t)(b * SEQ + tok) * DIN + kcol);
        float s = bias;
#pragma unroll
        for (int c = 0; c < 8; ++c) { const uint4 v = kp[c]; const unsigned w[4] = {v.x, v.y, v.z, v.w};
#pragma unroll
            for (int e = 0; e < 4; ++e) { s += q[c * 8 + 2 * e] * __uint_as_float(w[e] << 16); s += q[c * 8 + 2 * e + 1] * __uint_as_float(w[e] & 0xffff0000u); } }
        const float mn = fmaxf(m, s), f = exp2f(m - mn), p = exp2f(s - mn);
        l = l * f + p; m = mn;
        const uint4* vp = (const uint4*)(proj + (size_t)(b * SEQ + tok) * DIN + vcol);
#pragma unroll
        for (int c = 0; c < 8; ++c) { const uint4 v = vp[c]; const unsigned w[4] = {v.x, v.y, v.z, v.w};
#pragma unroll
            for (int e = 0; e < 4; ++e) { o[c * 8 + 2 * e] = o[c * 8 + 2 * e] * f + p * __uint_as_float(w[e] << 16); o[c * 8 + 2 * e + 1] = o[c * 8 + 2 * e + 1] * f + p * __uint_as_float(w[e] & 0xffff0000u); } }
    }
    const float il = 1.f / l;
    bf16_t* op = obuf + (size_t)row * OB_LD + ocol;
#pragma unroll
    for (int d = 0; d < 64; d += 2) *(unsigned*)(op + d) = (unsigned)f2bf(o[d] * il) | ((unsigned)f2bf(o[d + 1] * il) << 16);
    if (MODE == 1) lse[((size_t)pat * M + row) * 6 + h] = m + log2f(l);
}
__global__ __launch_bounds__(256) void k_mixfin(const bf16_t* __restrict__ obuf, const float* __restrict__ lse, const float* __restrict__ og, bf16_t* mix) {
    const int row = blockIdx.x * 4 + (threadIdx.x >> 6), lane = threadIdx.x & 63;
    const bf16_t* ob = obuf + (size_t)row * OB_LD; bf16_t* mo = mix + (size_t)row * DM;
    { const uint2 v = *(const uint2*)(ob + lane * 4);
      const float a0 = __uint_as_float(v.x << 16), a1 = __uint_as_float(v.x & 0xffff0000u), a2 = __uint_as_float(v.y << 16), a3 = __uint_as_float(v.y & 0xffff0000u);
      const float ss = wave_sum((a0 * a0 + a1 * a1) + (a2 * a2 + a3 * a3)); const float rs = rsqrtf(ss * (1.f / 256.f) + EPS);
      const float4 g = *(const float4*)(og + lane * 4);
      uint2 o; o.x = (unsigned)f2bf(a0 * rs * g.x) | ((unsigned)f2bf(a1 * rs * g.y) << 16); o.y = (unsigned)f2bf(a2 * rs * g.z) | ((unsigned)f2bf(a3 * rs * g.w) << 16);
      *(uint2*)(mo + lane * 4) = o; }
    { float v[6]; float ss = 0.f;
#pragma unroll
      for (int j = 0; j < 6; ++j) {
          const float l0 = lse[((size_t)0 * M + row) * 6 + j], l1 = lse[((size_t)1 * M + row) * 6 + j], l2 = lse[((size_t)2 * M + row) * 6 + j];
          const float mx = fmaxf(l0, fmaxf(l1, l2)); const float w0 = exp2f(l0 - mx), w1 = exp2f(l1 - mx), w2 = exp2f(l2 - mx); const float iw = 1.f / (w0 + w1 + w2);
          v[j] = (w0 * bf2f(ob[256 + j * 64 + lane]) + w1 * bf2f(ob[1024 + j * 64 + lane]) + w2 * bf2f(ob[1408 + j * 64 + lane])) * iw; ss += v[j] * v[j]; }
      ss = wave_sum(ss); const float rs = rsqrtf(ss * (1.f / 384.f) + EPS);
#pragma unroll
      for (int j = 0; j < 6; ++j) mo[256 + j * 64 + lane] = f2bf(v[j] * rs * og[256 + j * 64 + lane]); }
    { float v[6]; float ss = 0.f;
#pragma unroll
      for (int j = 0; j < 6; ++j) { v[j] = bf2f(ob[640 + j * 64 + lane]); ss += v[j] * v[j]; }
      ss = wave_sum(ss); const float rs = rsqrtf(ss * (1.f / 384.f) + EPS);
#pragma unroll
      for (int j = 0; j < 6; ++j) mo[640 + j * 64 + lane] = f2bf(v[j] * rs * og[640 + j * 64 + lane]); }
}
__global__ __launch_bounds__(256) void k_conv(const float* __restrict__ tmp, int row0, const float* __restrict__ cw, const float* __restrict__ cb, bf16_t* act) {
    const int idx = blockIdx.x * 256 + threadIdx.x, r = idx / DFF, c = idx % DFF;
    const float g0 = r > 0 ? tmp[(size_t)(r - 1) * 2 * DFF + c] : 0.f, g1 = tmp[(size_t)r * 2 * DFF + c], g2 = r < SEQ - 1 ? tmp[(size_t)(r + 1) * 2 * DFF + c] : 0.f;
    const float u = tmp[(size_t)r * 2 * DFF + DFF + c];
    const float g = g0 * cw[c] + cb[c] + g1 * cw[DFF + c] + g2 * cw[2 * DFF + c];
    act[(size_t)(row0 + r) * DFF + c] = f2bf(0.5f * g * (1.f + erff(g * 0.70710678118654752f)) * u);
}

#endif

namespace pg8 {
#define PG8_LAS __attribute__((address_space(3)))
#ifndef WGM_SEL
#define WGM_SEL 2
#endif
typedef unsigned short bf16_t;
typedef short bf16x8 __attribute__((ext_vector_type(8)));
typedef float f32x4 __attribute__((ext_vector_type(4)));
typedef unsigned u32x4 __attribute__((ext_vector_type(4)));
constexpr int BM = 256, BK = 64, HALF = 128, HTB = HALF * BK * 2  , STAGE_BYTES = 8 * HTB, NXCD = 8, WGM = WGM_SEL;

__host__ __device__ __forceinline__ int lds_byte(int r, int c) { const int st = (r >> 4) * 2 + (c >> 5), rr = r & 15, cc = c & 31, ob = rr * 64 + cc * 2; return st * 1024 + (ob ^ (((ob >> 9) & 1) << 5)); }
__host__ __device__ __forceinline__ void stage_rc(int b, int& R, int& C) { const int st = b / 1024, sb = b % 1024, swz = sb ^ (((sb >> 9) & 1) << 5); R = (st >> 1) * 16 + swz / 64; C = (st & 1) * 32 + (swz % 64) / 2; }
__host__ __device__ __forceinline__ int perm32(int rho) { const int n = rho >> 4, i = rho & 15; return 8 * (i >> 2) + 4 * n + (i & 3); }

struct Unit { int pm, pn; };
struct Gemm { const bf16_t* A; const bf16_t* Bt; int M, N, K; int a_step, a_off; };

struct StaticOrder {
    int nM, nN, nwg, G, c; static constexpr int wgm = WGM, nmaj = 0;
    __host__ __device__ void init(int M, int N, int G_, int c_) { nM = M / BM; nN = N / BM; nwg = nM * nN; G = G_; c = c_; }
    __host__ __device__ void init2(int nM_, int nN_, int G_, int c_) { nM = nM_; nN = nN_; nwg = nM * nN; G = G_; c = c_; }
    __host__ __device__ bool next(int i, Unit& u) const {
        const long L = (long)i * G + c; if (L >= nwg) return false;
        int wgid = (int)L; { const int q = nwg / NXCD, r = nwg % NXCD, xcd = wgid % NXCD, off = wgid / NXCD; wgid = (xcd < r ? xcd * (q + 1) : r * (q + 1) + (xcd - r) * q) + off; }
        const int nig = wgm * nN, gid = wgid / nig, fm = gid * wgm, gsz = (nM - fm) < wgm ? (nM - fm) : wgm;
        if (nmaj) { const int nig2 = wgm * nM, gid2 = wgid / nig2, fn = gid2 * wgm, gs2 = (nN - fn) < wgm ? (nN - fn) : wgm; u.pn = fn + ((wgid % nig2) % gs2); u.pm = (wgid % nig2) / gs2; return true; }
        u.pm = fm + ((wgid % nig) % gsz); u.pn = (wgid % nig) / gsz; return true;
    }
    __device__ __forceinline__ void a_ready(const Unit&) const {}
    __device__ __forceinline__ void done(const Unit&) const {}
};

__device__ __forceinline__ unsigned cvt_pk_bf16(float lo, float hi) { unsigned r; asm volatile("v_cvt_pk_bf16_f32 %0, %1, %2" : "=v"(r) : "v"(lo), "v"(hi)); return r; }
typedef float f32x2 __attribute__((ext_vector_type(2)));
__device__ __forceinline__ f32x2 gelu_pk(f32x2 v) {
    f32x2 nav; nav.x = __uint_as_float(__float_as_uint(v.x) | 0x80000000u); nav.y = __uint_as_float(__float_as_uint(v.y) | 0x80000000u);
    const f32x2 d = nav * (-0.2316418882f) + 1.0f;
    f32x2 t; t.x = __builtin_amdgcn_rcpf(d.x); t.y = __builtin_amdgcn_rcpf(d.y);
    f32x2 q = t * 0.5307027145f + (-0.7265760135f); q = q * t + 0.7107068705f; q = q * t + (-0.142248368f); q = q * t + 0.127414796f; q = q * t;
    const f32x2 s = (v * v) * (-0.72134752044f);
    f32x2 e; e.x = __builtin_amdgcn_exp2f(s.x); e.y = __builtin_amdgcn_exp2f(s.y);
    f32x2 rl; rl.x = __builtin_fmaxf(v.x, 0.f); rl.y = __builtin_fmaxf(v.y, 0.f);
    return nav * (q * e) + rl;
}
__device__ __forceinline__ float row_rstd_g(const float* ssp, int row) {
    const f32x4* p = (const f32x4*)(ssp + (size_t)row * 16);
    const f32x4 a = p[0], b = p[1], c = p[2], d = p[3];
    const float s = ((a[0] + a[1]) + (a[2] + a[3])) + ((b[0] + b[1]) + (b[2] + b[3])) + ((c[0] + c[1]) + (c[2] + c[3])) + ((d[0] + d[1]) + (d[2] + d[3]));
    return __builtin_amdgcn_rsqf(s * (1.0f / 1024.0f) + 1e-6f);
}
typedef float f32x2v __attribute__((ext_vector_type(2)));
#ifndef NT_EPI
#define NT_EPI 0
#endif
#if NT_EPI
#define NT_STORE16(p, v) __builtin_nontemporal_store((v), (p))
#else
#define NT_STORE16(p, v) (*(p) = (v))
#endif
__device__ __forceinline__ f32x2 gelu_poly_pk(f32x2 v) {
    const f32x2 z = v * 0.70710678118654752f; f32x2 zc; zc.x = __builtin_amdgcn_fmed3f(z.x, -3.6f, 3.6f); zc.y = __builtin_amdgcn_fmed3f(z.y, -3.6f, 3.6f);
    const f32x2 u = (zc * zc) * (2.0f / 12.96f) - 1.0f;
    f32x2 p = u * 2.149422857e-03f + (-5.741538245e-03f);
    p = p * u + 5.897893566e-03f; p = p * u + (-8.305349284e-03f); p = p * u + 1.989052295e-02f; p = p * u + (-3.436241872e-02f); p = p * u + 4.892587253e-02f;
    p = p * u + (-6.755373953e-02f); p = p * u + 8.967999166e-02f; p = p * u + (-1.138468536e-01f); p = p * u + 1.438208186e-01f; p = p * u + (-1.954888562e-01f); p = p * u + 3.927120064e-01f;
    const f32x2 h = v * 0.5f; return h * (zc * p) + h;
}
__device__ __forceinline__ float quad_row_sum(float s) {
    { const auto a = __builtin_amdgcn_permlane16_swap(__float_as_uint(s), __float_as_uint(s), false, false); s = __uint_as_float(a[0]) + __uint_as_float(a[1]); }
    { const auto b = __builtin_amdgcn_permlane32_swap(__float_as_uint(s), __float_as_uint(s), false, false); s = __uint_as_float(b[0]) + __uint_as_float(b[1]); }
    return s;
}
__device__ __forceinline__ float row_rstd_q(const float* ssp, int row, int fq) {
    const f32x4 a = *((const f32x4*)(ssp + (size_t)row * 16) + fq);
    float s = (a[0] + a[1]) + (a[2] + a[3]); s = quad_row_sum(s);
    return __builtin_amdgcn_rsqf(s * (1.0f / 1024.0f) + 1e-6f);
}
struct EpiIn {
    static constexpr bool PERM = true, AFTER_DRAIN = false;
    bf16_t* proj; const float* ssp; const float* qg; const float* kg; const f32x2v* rot1; const f32x2v* rotax;
    __device__ __forceinline__ void operator()(const f32x4 (&acc)[2][2][4][2], const Unit& u, int wr, int wc, int fr, int fq) const {
        asm volatile("" : "+v"(fr), "+v"(fq));
        const int hd = u.pn * 4 + wc;
        int mixer, isq, isv = 0;
        if (hd < 4) { mixer = 0; isq = 1; } else if (hd < 8) { mixer = 0; isq = 0; } else if (hd < 12) { mixer = 0; isq = 0; isv = 1; }
        else if (hd < 18) { mixer = 1; isq = 1; } else if (hd < 24) { mixer = 1; isq = 0; } else if (hd < 30) { mixer = 1; isq = 0; isv = 1; }
        else if (hd < 36) { mixer = 2; isq = 1; } else if (hd < 38) { mixer = 2; isq = 0; } else { mixer = 2; isq = 0; isv = 1; }
        int cb[2];
        if (isv || mixer == 0) { cb[0] = 8 * fq; cb[1] = 32 + 8 * fq; }
        else if (mixer == 1) { if (fq == 0) { cb[0] = 0; cb[1] = 8; } else { cb[0] = 8 * fq + 8; cb[1] = 8 * fq + 32; } }
        else { if (fq < 2) { cb[0] = 8 * fq; cb[1] = 16 + 8 * fq; } else { cb[0] = 8 * fq + 16; cb[1] = 8 * fq + 32; } }
        f32x4 gv[2][2];
        const float* g = (isq ? qg : kg) + mixer * 64; const float sc = isq ? 0.125f * 1.4426950408889634f : 1.f;
#pragma unroll
        for (int bj = 0; bj < 2; ++bj)
#pragma unroll
            for (int n = 0; n < 2; ++n) gv[bj][n] = isv ? (f32x4){1.f, 1.f, 1.f, 1.f} : *(const f32x4*)(g + cb[bj] + 4 * n) * sc;
        const int rowb = u.pm * BM + wr * 64 + fr;
        float rsv[8];
        { f32x4 sa[4], sb[4];
#pragma unroll
          for (int i = 0; i < 4; ++i) sa[i] = *((const f32x4*)(ssp + (size_t)(rowb + i * 16) * 16) + fq);
#pragma unroll
          for (int i = 0; i < 4; ++i) sb[i] = *((const f32x4*)(ssp + (size_t)(rowb + HALF + i * 16) * 16) + fq);
#pragma unroll
          for (int i = 0; i < 4; ++i) rsv[i] = __builtin_amdgcn_rsqf(quad_row_sum((sa[i][0] + sa[i][1]) + (sa[i][2] + sa[i][3])) * (1.0f / 1024.0f) + 1e-6f);
#pragma unroll
          for (int i = 0; i < 4; ++i) rsv[4 + i] = __builtin_amdgcn_rsqf(quad_row_sum((sb[i][0] + sb[i][1]) + (sb[i][2] + sb[i][3])) * (1.0f / 1024.0f) + 1e-6f);
          asm volatile("" : "+v"(rsv[0]), "+v"(rsv[1]), "+v"(rsv[2]), "+v"(rsv[3]), "+v"(rsv[4]), "+v"(rsv[5]), "+v"(rsv[6]), "+v"(rsv[7])); }
        const bool rot = !isv && mixer != 0 && (mixer == 2 || fq == 0);
        auto tabp = [&](int row) -> const f32x4* { const int t = row & 4095; return (const f32x4*)(mixer == 1 ? (rot1 + t * 8) : (rotax + ((fq < 2) ? (t >> 6) : (t & 63)) * 16 + (fq & 1) * 8)); };
        f32x4 tb[2][4];
        if (rot) { const f32x4* p = tabp(rowb);
#pragma unroll
            for (int k = 0; k < 4; ++k) tb[0][k] = p[k]; }
#pragma unroll
        for (int i = 0; i < 8; ++i) {
            const int ai = i >> 2, m = i & 3; const int row = rowb + ai * HALF + m * 16;
            if (rot && i < 7) { const f32x4* p = tabp(rowb + ((i + 1) >> 2) * HALF + ((i + 1) & 3) * 16);
#pragma unroll
                for (int k = 0; k < 4; ++k) tb[(i + 1) & 1][k] = p[k]; }
            const float rs = rsv[i];
            f32x4 v[2][2];
#pragma unroll
            for (int bj = 0; bj < 2; ++bj)
#pragma unroll
                for (int n = 0; n < 2; ++n) v[bj][n] = acc[ai][bj][m][n] * rs;
            if (!isv) {
                float ss = 0.f; f32x2 s2 = {0.f, 0.f};
#pragma unroll
                for (int bj = 0; bj < 2; ++bj)
#pragma unroll
                    for (int n = 0; n < 2; ++n) { const f32x4 x = v[bj][n]; const f32x2 xa = {x[0], x[1]}, xb = {x[2], x[3]}; s2 = xa * xa + s2; s2 = xb * xb + s2; }
                ss = quad_row_sum(s2.x + s2.y);
                const float r2 = __builtin_amdgcn_rsqf(ss * (1.0f / 64.0f) + 1e-6f);
#pragma unroll
                for (int bj = 0; bj < 2; ++bj)
#pragma unroll
                    for (int n = 0; n < 2; ++n) v[bj][n] = v[bj][n] * r2 * gv[bj][n];
                if (rot) {
#pragma unroll
                    for (int n = 0; n < 2; ++n)
#pragma unroll
                        for (int e = 0; e < 4; ++e) { const f32x4 q = tb[i & 1][2 * n + (e >> 1)]; const float c = q[2 * (e & 1)], sn = q[2 * (e & 1) + 1]; const float a = v[0][n][e], b = v[1][n][e]; v[0][n][e] = __builtin_fmaf(a, c, -(b * sn)); v[1][n][e] = __builtin_fmaf(b, c, a * sn); }
                }
            }
            bf16_t* rowp = proj + (size_t)row * 2560 + hd * 64;
#pragma unroll
            for (int bj = 0; bj < 2; ++bj) { u32x4 w; w.x = cvt_pk_bf16(v[bj][0][0], v[bj][0][1]); w.y = cvt_pk_bf16(v[bj][0][2], v[bj][0][3]); w.z = cvt_pk_bf16(v[bj][1][0], v[bj][1][1]); w.w = cvt_pk_bf16(v[bj][1][2], v[bj][1][3]);
                NT_STORE16((u32x4*)(rowp + cb[bj]), w); }
            asm volatile("" ::: "memory");
        }
    }
};
struct EpiRes {
    static constexpr bool PERM = false, AFTER_DRAIN = false;
    const float* res; float* out; bf16_t* xb; float* sspo;
    __device__ __forceinline__ void operator()(const f32x4 (&acc)[2][2][4][2], const Unit& u, int wr, int wc, int fr, int fq) const {
        asm volatile("" : "+v"(fr), "+v"(fq));
        const int col0 = u.pn * BM + wc * 32 + 4 * fq;
        const size_t off0 = (size_t)(u.pm * BM + wr * 64 + fr) * 1024 + col0;
        f32x4 rb[2][2][2];
#pragma unroll
        for (int bj = 0; bj < 2; ++bj)
#pragma unroll
            for (int n = 0; n < 2; ++n) rb[0][bj][n] = *(const f32x4*)(res + off0 + bj * HALF + n * 16);
#pragma unroll
        for (int i = 0; i < 8; ++i) {
            const int ai = i >> 2, m = i & 3; const int row = u.pm * BM + ai * HALF + wr * 64 + m * 16 + fr; const size_t off = (size_t)row * 1024 + col0; f32x2 s2 = {0.f, 0.f};
            if (i < 7) { const size_t offn = off0 + (size_t)(((i + 1) >> 2) * HALF + ((i + 1) & 3) * 16) * 1024;
#pragma unroll
                for (int bj = 0; bj < 2; ++bj)
#pragma unroll
                    for (int n = 0; n < 2; ++n) rb[(i + 1) & 1][bj][n] = *(const f32x4*)(res + offn + bj * HALF + n * 16); }
#pragma unroll
            for (int bj = 0; bj < 2; ++bj)
#pragma unroll
                for (int n = 0; n < 2; ++n) { const size_t o2 = off + bj * HALF + n * 16; const f32x4 o = rb[i & 1][bj][n] + acc[ai][bj][m][n]; *(f32x4*)(out + o2) = o;
                    { const f32x2 oa = {o[0], o[1]}, ob = {o[2], o[3]}; s2 = oa * oa + s2; s2 = ob * ob + s2; }
                    if (xb) { f32x2v w; w.x = __uint_as_float(cvt_pk_bf16(o[0], o[1])); w.y = __uint_as_float(cvt_pk_bf16(o[2], o[3])); *(f32x2v*)(xb + o2) = w; } }
            if (sspo) { const float ss = quad_row_sum(s2.x + s2.y); if (fq == 0) sspo[(size_t)row * 16 + u.pn * 4 + wc] = ss; }
            asm volatile("" ::: "memory");
        }
    }
};
template <int CTRL> __device__ __forceinline__ float dpp_mov(float v) { return __uint_as_float((unsigned)__builtin_amdgcn_mov_dpp((int)__float_as_uint(v), CTRL, 0xf, 0xf, true)); }
struct EpiGateConv {
    static constexpr bool PERM = true, AFTER_DRAIN = false;
    bf16_t* act; const float* ssp; const float* cw; const float* cb; PG8_LAS float* halo; int cheap;
    __device__ __forceinline__ void operator()(f32x4 (&acc)[2][2][4][2], const Unit& u, int wr, int wc, int fr, int fq) const {
        asm volatile("" : "+v"(fr), "+v"(fq));
        const int grow0 = 254 * u.pm - 1, lr0 = wr * 64 + fr;
        {
            f32x4 sv[2][4];
#pragma unroll
            for (int ai = 0; ai < 2; ++ai)
#pragma unroll
                for (int m = 0; m < 4; ++m) { int gr = grow0 + lr0 + ai * HALF + m * 16; gr = gr < 0 ? 0 : (gr > 32767 ? 32767 : gr); sv[ai][m] = *((const f32x4*)(ssp + (size_t)gr * 16) + fq); }
#pragma unroll
            for (int ai = 0; ai < 2; ++ai)
#pragma unroll
                for (int m = 0; m < 4; ++m) { const f32x4 a = sv[ai][m]; const float s_ = quad_row_sum((a[0] + a[1]) + (a[2] + a[3])); const float rs = __builtin_amdgcn_rsqf(s_ * (1.0f / 1024.0f) + 1e-6f);
#pragma unroll
                    for (int bj = 0; bj < 2; ++bj)
#pragma unroll
                        for (int n = 0; n < 2; ++n) acc[ai][bj][m][n] *= rs;
                    asm volatile("" : "+v"(acc[ai][0][m][0]), "+v"(acc[ai][0][m][1]), "+v"(acc[ai][1][m][0]), "+v"(acc[ai][1][m][1])); }
        }
        const int hc = wc * 32 + 8 * fq;
        const int ch0 = 128 * u.pn + hc;
        f32x4 wq[4]; wq[0] = *(const f32x4*)(cw + ch0); wq[1] = *(const f32x4*)(cw + 2816 + ch0); wq[2] = *(const f32x4*)(cw + 5632 + ch0); wq[3] = *(const f32x4*)(cb + ch0);
#pragma unroll
        for (int ai = 0; ai < 2; ++ai) { const int blk = 2 * ai + wr;
            if (fr == 0) { *(PG8_LAS f32x4*)(halo + (blk * 2 + 0) * 128 + hc) = acc[ai][0][0][0]; *(PG8_LAS f32x4*)(halo + (blk * 2 + 0) * 128 + hc + 4) = acc[ai][0][0][1]; }
            if (fr == 15) { *(PG8_LAS f32x4*)(halo + (blk * 2 + 1) * 128 + hc) = acc[ai][0][3][0]; *(PG8_LAS f32x4*)(halo + (blk * 2 + 1) * 128 + hc + 4) = acc[ai][0][3][1]; } }
        asm volatile("s_waitcnt lgkmcnt(0)" ::: "memory"); __builtin_amdgcn_s_barrier(); asm volatile("" ::: "memory");
        if (!cheap)
#pragma unroll
        for (int n = 0; n < 2; ++n) {
            const f32x4 w0 = wq[0], w1 = wq[1], w2 = wq[2], bb = wq[3];
            if (n == 0) { wq[0] = *(const f32x4*)(cw + ch0 + 4); wq[1] = *(const f32x4*)(cw + 2816 + ch0 + 4); wq[2] = *(const f32x4*)(cw + 5632 + ch0 + 4); wq[3] = *(const f32x4*)(cb + ch0 + 4); }
#pragma unroll
            for (int ai = 0; ai < 2; ++ai) {
                const int blk = 2 * ai + wr;
                const f32x4 hp = blk > 0 ? *(PG8_LAS f32x4*)(halo + ((blk - 1) * 2 + 1) * 128 + hc + 4 * n) : (f32x4){0.f, 0.f, 0.f, 0.f};
                const f32x4 hn = blk < 3 ? *(PG8_LAS f32x4*)(halo + ((blk + 1) * 2 + 0) * 128 + hc + 4 * n) : (f32x4){0.f, 0.f, 0.f, 0.f};
#pragma unroll
                for (int e2 = 0; e2 < 4; e2 += 2) {
                    float gcv[4][2];
#pragma unroll
                    for (int ee = 0; ee < 2; ++ee) { const int e = e2 + ee;
                        float rr[4], ll[4];
                        float gsrc[4] = {acc[ai][0][0][n][e], acc[ai][0][1][n][e], acc[ai][0][2][n][e], acc[ai][0][3][n][e]};
                        asm volatile("" : "+v"(gsrc[0]), "+v"(gsrc[1]), "+v"(gsrc[2]), "+v"(gsrc[3]));
#pragma unroll
                        for (int m = 0; m < 4; ++m) { rr[m] = dpp_mov<0x121>(gsrc[m]); ll[m] = dpp_mov<0x12F>(gsrc[m]); }
#pragma unroll
                        for (int m = 0; m < 4; ++m) {
                            const int lr = lr0 + ai * HALF + m * 16, tt = (grow0 + lr) & 4095;
                            float up = fr > 0 ? rr[m] : (m > 0 ? rr[m > 0 ? m - 1 : 0] : hp[e]);
                            float dn = fr < 15 ? ll[m] : (m < 3 ? ll[m < 3 ? m + 1 : 3] : hn[e]);
                            if (tt == 0) up = 0.f;
                            if (tt == 4095) dn = 0.f;
                            float gc = __builtin_fmaf(up, w0[e], bb[e]); gc = __builtin_fmaf(gsrc[m], w1[e], gc); gc = __builtin_fmaf(dn, w2[e], gc);
                            gcv[m][ee] = gc;
                        }
                    }
#pragma unroll
                    for (int m = 0; m < 4; ++m) { const f32x2 a = gelu_pk((f32x2){gcv[m][0], gcv[m][1]}); acc[ai][0][m][n][e2] = a.x * acc[ai][1][m][n][e2]; acc[ai][0][m][n][e2 + 1] = a.y * acc[ai][1][m][n][e2 + 1]; }
                    asm volatile("" : "+v"(acc[ai][0][0][n]), "+v"(acc[ai][0][1][n]), "+v"(acc[ai][0][2][n]), "+v"(acc[ai][0][3][n]));
                }
            }
            asm volatile("" ::: "memory");
        }
#pragma unroll
        for (int ai = 0; ai < 2; ++ai)
#pragma unroll
            for (int m = 0; m < 4; ++m) {
                const int lr = lr0 + ai * HALF + m * 16, gr = grow0 + lr;
                if (lr >= 1 && lr <= 254 && gr < 32768) { const f32x4 o0 = acc[ai][0][m][0], o1 = acc[ai][0][m][1];
                    u32x4 w; w.x = cvt_pk_bf16(o0[0], o0[1]); w.y = cvt_pk_bf16(o0[2], o0[3]); w.z = cvt_pk_bf16(o1[0], o1[1]); w.w = cvt_pk_bf16(o1[2], o1[3]);
                    NT_STORE16((u32x4*)(act + (size_t)gr * 2816 + ch0), w); }
            }
    }
};
template <class Epi, class Sched, bool ALIGN_EPI = false, bool SP2 = false>
__device__ __forceinline__ void gemm_phase(PG8_LAS unsigned char* lds, const Gemm g, const Sched& S, const Epi& E, int tid_in) {
    const int tid = tid_in, wid = __builtin_amdgcn_readfirstlane(tid >> 6), lane = tid & 63, wr = wid >> 2, wc = wid & 3, fr = lane & 15, fq = lane >> 4;
    const int K = g.K, nt = K / BK;
    unsigned voffA[2], voffB[2];
#pragma unroll
    for (int i = 0; i < 2; ++i) { int R, C; stage_rc(tid * 16 + i * 8192, R, C); const int Rb = Epi::PERM ? ((R & ~31) + perm32(R & 31)) : R;
        voffA[i] = (unsigned)(R * K + C) * 2u; voffB[i] = (unsigned)(Rb * K + C) * 2u; }
    const size_t kstep = (size_t)(BK * 2);
    const size_t hstep = (size_t)HALF * K * 2;
    const size_t tstep = 2 * hstep;
    const unsigned ldsw = (unsigned)wid * 1024u;
    const int aoff = lds_byte(wr * 64 + fr, fq * 8), boff = lds_byte(wc * 32 + fr, fq * 8);
#define PG8_SA(b, h) (((b) * 2 + (h)) * HTB)
#define PG8_SB(b, h) ((4 + (b) * 2 + (h)) * HTB)
#define PG8_STAGE(bufoff, gbase, voff) do { _Pragma("unroll") for (int _i = 0; _i < 2; ++_i) \
        __builtin_amdgcn_global_load_lds((const unsigned*)((const char*)(gbase) + (voff)[_i]), (PG8_LAS unsigned*)(lds + (bufoff) + ldsw + _i * 8192), 16, 0, 0); } while (0)
#ifndef B_AUX
#define B_AUX 0
#endif
#define PG8_STAGEB(bufoff, gbase, voff) do { _Pragma("unroll") for (int _i = 0; _i < 2; ++_i) \
        __builtin_amdgcn_global_load_lds((const unsigned*)((const char*)(gbase) + (voff)[_i]), (PG8_LAS unsigned*)(lds + (bufoff) + ldsw + _i * 8192), 16, 0, B_AUX); } while (0)
#define PG8_LDA(dst, b, h) do { _Pragma("unroll") for (int m = 0; m < 4; ++m) _Pragma("unroll") for (int k = 0; k < 2; ++k) dst[m][k] = *(const PG8_LAS bf16x8*)(lds + PG8_SA(b, h) + aoff + m * 2048 + k * 1024); } while (0)
#define PG8_LDB(dst, b, h) do { _Pragma("unroll") for (int n = 0; n < 2; ++n) _Pragma("unroll") for (int k = 0; k < 2; ++k) dst[n][k] = *(const PG8_LAS bf16x8*)(lds + PG8_SB(b, h) + boff + n * 2048 + k * 1024); } while (0)
#define PG8_MMA(ai, bj, At, Bt) do { __builtin_amdgcn_s_setprio(1); _Pragma("unroll") for (int m = 0; m < 4; ++m) _Pragma("unroll") for (int n = 0; n < 2; ++n) _Pragma("unroll") for (int k = 0; k < 2; ++k) \
        acc[ai][bj][m][n] = __builtin_amdgcn_mfma_f32_16x16x32_bf16(Bt[n][k], At[m][k], acc[ai][bj][m][n], 0, 0, 0); __builtin_amdgcn_s_setprio(0); } while (0)
#define PG8_WAIT_V(n) asm volatile("s_waitcnt vmcnt(" #n ")" ::: "memory")
#define PG8_WAIT_L(n) asm volatile("s_waitcnt lgkmcnt(" #n ")" ::: "memory")
#define PG8_BAR __builtin_amdgcn_s_barrier()
#define PG8_SCHED __builtin_amdgcn_sched_barrier(0)
    Unit cur, nxt; int ui = 0;
    if (!S.next(0, cur)) return;
    f32x4 acc[2][2][4][2];
#pragma unroll
    for (int a = 0; a < 2; ++a)
#pragma unroll
        for (int b = 0; b < 2; ++b)
#pragma unroll
            for (int m = 0; m < 4; ++m)
#pragma unroll
                for (int n = 0; n < 2; ++n) acc[a][b][m][n] = (f32x4){0.f, 0.f, 0.f, 0.f};
    bf16x8 At[4][2], B0[2][2], B1[2][2];
    const char* cA = (const char*)g.A + ((long)cur.pm * g.a_step + g.a_off) * (long)(K * 2); const char* cB = (const char*)g.Bt + (size_t)cur.pn * tstep;
    S.a_ready(cur);
    if constexpr (SP2) {
        PG8_STAGEB(PG8_SB(0, 0), cB, voffB); PG8_STAGEB(PG8_SB(0, 1), cB + hstep, voffB); PG8_STAGE(PG8_SA(0, 0), cA, voffA); PG8_STAGE(PG8_SA(0, 1), cA + hstep, voffA);
        if (wr == 1) PG8_BAR;
        PG8_WAIT_V(2); PG8_BAR;
        PG8_STAGEB(PG8_SB(1, 0), cB + kstep, voffB); PG8_STAGE(PG8_SA(1, 0), cA + kstep, voffA); PG8_STAGEB(PG8_SB(1, 1), cB + hstep + kstep, voffB);
        PG8_WAIT_V(6); PG8_BAR;
    } else {
        PG8_STAGEB(PG8_SB(0, 0), cB, voffB); PG8_STAGE(PG8_SA(0, 0), cA, voffA); PG8_STAGEB(PG8_SB(0, 1), cB + hstep, voffB); PG8_STAGE(PG8_SA(0, 1), cA + hstep, voffA);
        if (wr == 1) PG8_BAR;
        PG8_WAIT_V(4); PG8_BAR;
        PG8_STAGEB(PG8_SB(1, 0), cB + kstep, voffB); PG8_STAGE(PG8_SA(1, 0), cA + kstep, voffA); PG8_STAGEB(PG8_SB(1, 1), cB + hstep + kstep, voffB);
        PG8_WAIT_V(6); PG8_BAR;
    }
    for (;;) {
        const bool has_next = S.next(ui + 1, nxt);
        const char* nA = has_next ? (const char*)g.A + ((long)nxt.pm * g.a_step + g.a_off) * (long)(K * 2) : cA; const char* nB = has_next ? (const char*)g.Bt + (size_t)nxt.pn * tstep : cB;
        for (int t = 0; t < nt; t += 2) {
            const bool last = (t == nt - 2);
            const char* a1 = cA + (size_t)(t + 1) * kstep;
            const char* a2 = last ? nA : cA + (size_t)(t + 2) * kstep; const char* b2 = last ? nB : cB + (size_t)(t + 2) * kstep;
            const char* a3 = a2 + kstep; const char* b3 = b2 + kstep;
            if (last && has_next) S.a_ready(nxt);
            if constexpr (SP2) {
            PG8_LDB(B0, 0, 0); PG8_LDB(B1, 0, 1); PG8_SCHED; PG8_LDA(At, 0, 0); PG8_STAGE(PG8_SA(1, 1), a1 + hstep, voffA);
            PG8_WAIT_V(8); PG8_WAIT_L(0); PG8_BAR; PG8_MMA(0, 0, At, B0); PG8_MMA(0, 1, At, B1); PG8_BAR; PG8_SCHED;
            PG8_LDA(At, 0, 1); PG8_STAGEB(PG8_SB(0, 0), b2, voffB); PG8_STAGEB(PG8_SB(0, 1), b2 + hstep, voffB); PG8_STAGE(PG8_SA(0, 0), a2, voffA);
            PG8_WAIT_V(8); PG8_WAIT_L(0); PG8_BAR; PG8_MMA(1, 0, At, B0); PG8_MMA(1, 1, At, B1); PG8_BAR; PG8_SCHED;
            PG8_LDB(B0, 1, 0); PG8_LDB(B1, 1, 1); PG8_SCHED; PG8_LDA(At, 1, 0); PG8_STAGE(PG8_SA(0, 1), a2 + hstep, voffA);
            PG8_WAIT_V(8); PG8_WAIT_L(0); PG8_BAR; PG8_MMA(0, 0, At, B0); PG8_MMA(0, 1, At, B1); PG8_BAR; PG8_SCHED;
            PG8_LDA(At, 1, 1); PG8_STAGEB(PG8_SB(1, 0), b3, voffB); PG8_STAGEB(PG8_SB(1, 1), b3 + hstep, voffB); PG8_STAGE(PG8_SA(1, 0), a3, voffA);
            PG8_WAIT_V(8); PG8_WAIT_L(0); PG8_BAR; PG8_MMA(1, 0, At, B0); PG8_MMA(1, 1, At, B1); PG8_BAR; PG8_SCHED;
            } else {
            PG8_LDB(B0, 0, 0); PG8_SCHED; PG8_LDA(At, 0, 0); PG8_STAGE(PG8_SA(1, 1), a1 + hstep, voffA);
            PG8_WAIT_L(8); PG8_BAR; PG8_WAIT_L(0); PG8_MMA(0, 0, At, B0); PG8_BAR; PG8_SCHED;
            PG8_LDB(B1, 0, 1); PG8_STAGEB(PG8_SB(0, 0), b2, voffB);
            PG8_BAR; PG8_WAIT_L(0); PG8_MMA(0, 1, At, B1); PG8_BAR;
            PG8_LDA(At, 0, 1); PG8_STAGE(PG8_SA(0, 0), a2, voffA);
            PG8_BAR; PG8_WAIT_L(0); PG8_MMA(1, 0, At, B0); PG8_BAR; PG8_SCHED;
            PG8_STAGEB(PG8_SB(0, 1), b2 + hstep, voffB);
            PG8_WAIT_V(6); PG8_BAR; PG8_MMA(1, 1, At, B1); PG8_BAR;
            PG8_LDB(B0, 1, 0); PG8_SCHED; PG8_LDA(At, 1, 0); PG8_STAGE(PG8_SA(0, 1), a2 + hstep, voffA);
            PG8_WAIT_L(8); PG8_BAR; PG8_WAIT_L(0); PG8_MMA(0, 0, At, B0); PG8_BAR; PG8_SCHED;
            PG8_LDB(B1, 1, 1); PG8_STAGEB(PG8_SB(1, 0), b3, voffB);
            PG8_BAR; PG8_WAIT_L(0); PG8_MMA(0, 1, At, B1); PG8_BAR;
            PG8_LDA(At, 1, 1); PG8_STAGE(PG8_SA(1, 0), a3, voffA);
            PG8_BAR; PG8_WAIT_L(0); PG8_MMA(1, 0, At, B0); PG8_BAR; PG8_SCHED;
            PG8_STAGEB(PG8_SB(1, 1), b3 + hstep, voffB);
            PG8_WAIT_V(6); PG8_BAR; PG8_MMA(1, 1, At, B1); PG8_BAR;
            }
        }
        if constexpr (ALIGN_EPI) { if (wr == 0) PG8_BAR; }
        if constexpr (!Epi::AFTER_DRAIN) { E(acc, cur, wr, wc, fr, fq); S.done(cur); }
        if (!has_next) break;
#pragma unroll
        for (int a = 0; a < 2; ++a)
#pragma unroll
            for (int b = 0; b < 2; ++b)
#pragma unroll
                for (int m = 0; m < 4; ++m)
#pragma unroll
                    for (int n = 0; n < 2; ++n) acc[a][b][m][n] = (f32x4){0.f, 0.f, 0.f, 0.f};
        cur = nxt; cA = nA; cB = nB; ++ui;
        if constexpr (ALIGN_EPI) { if (wr == 1) PG8_BAR; }
    }
    PG8_WAIT_V(0);
    if constexpr (!ALIGN_EPI) { if (wr == 0) PG8_BAR; }
    PG8_BAR;
    if constexpr (Epi::AFTER_DRAIN) { E.fused(acc, cur, wr, wc, fr, fq, lds, wid, lane); S.done(cur); }
#undef PG8_SA
#undef PG8_SB
#undef PG8_STAGE
#undef PG8_STAGEB
#undef PG8_LDA
#undef PG8_LDB
#undef PG8_MMA
#undef PG8_WAIT_V
#undef PG8_WAIT_L
#undef PG8_BAR
#undef PG8_SCHED
}
}

#define ATTN_STORE16(p,v) (*(u32x4*)(p)=(v))
namespace attn_body {
using bf16=__hip_bfloat16;
using bf16x8=__attribute__((ext_vector_type(8)))short;
using s16x4=__attribute__((ext_vector_type(4)))short;
using f32x16=__attribute__((ext_vector_type(16)))float;
using u32x4=__attribute__((ext_vector_type(4)))unsigned;
constexpr int NW=8,QBLK=32,QB=QBLK*NW,KVBLK=64;
__device__ __forceinline__ int crow(int r,int hi){return (r&3)+8*(r>>2)+4*hi;}
#define SBAR() __builtin_amdgcn_sched_barrier(0)
__device__ __forceinline__ void cmask(f32x16&p0,f32x16&p1,int jb,int qrel,int hi){
  const float NEG=-INFINITY; int kb=64*jb+4*hi;
  #pragma unroll
  for(int r=0;r<16;++r){int kv=kb+(r&3)+8*(r>>2); if(kv>qrel)p0[r]=NEG; if(kv+32>qrel)p1[r]=NEG;}
}

constexpr int NSLOT=3, SLOTB=8192;
constexpr int LDS_K=0, LDS_V=NSLOT*SLOTB, LDS_WS=2*NSLOT*SLOTB, LDS_OST=LDS_WS+NW*64*4, LDS_BYTES=LDS_OST+NW*4096;
constexpr float C2=0.125f*1.4426950408889634f;
__device__ __forceinline__ void glds16(const void*gsrc,unsigned lds_dst){unsigned keep;
  asm volatile("s_mov_b32 %0, m0\n\ts_mov_b32 m0, %2\n\ts_nop 0\n\tglobal_load_lds_dwordx4 %1, off\n\ts_mov_b32 m0, %0":"=&s"(keep):"v"(gsrc),"s"(lds_dst):"memory");}
__device__ __forceinline__ float max3f(float a,float b,float c){float r;asm("v_max3_f32 %0, %1, %2, %3":"=v"(r):"v"(a),"v"(b),"v"(c));return r;}
__device__ __forceinline__ float max2f(float a,float b){float r;asm("v_max_f32_e32 %0, %1, %2":"=v"(r):"v"(a),"v"(b));return r;}
__device__ __forceinline__ float fadd_s(float a,float b){float r;asm("v_add_f32_e32 %0, %1, %2":"=v"(r):"v"(a),"v"(b));return r;}
__device__ __forceinline__ float fsub_s(float a,float b){float r;asm("v_sub_f32_e32 %0, %1, %2":"=v"(r):"v"(a),"v"(b));return r;}
typedef float f32x2_t __attribute__((ext_vector_type(2))); typedef __bf16 bf16x2_t __attribute__((ext_vector_type(2)));
__device__ __forceinline__ unsigned cvtpk_s(float lo,float hi){f32x2_t v={lo,hi};bf16x2_t b=__builtin_convertvector(v,bf16x2_t);return __builtin_bit_cast(unsigned,b);}
#define WAIT_BAR(N) asm volatile("s_waitcnt vmcnt(" #N ") lgkmcnt(0)\n\ts_barrier":::"memory")

__device__ __forceinline__ void qkt(f32x16&p0,f32x16&p1,const char*Kslot,const bf16x8*qr,const f32x16&negm,int r32,int hi){
  const char*kb=Kslot+hi*1024+r32*16;
  #pragma unroll
  for(int d0=0;d0<4;++d0){
    const bf16x8 b0=*reinterpret_cast<const bf16x8*>(kb+d0*2048);
    const bf16x8 b1=*reinterpret_cast<const bf16x8*>(kb+d0*2048+512);
    if(d0==0){p0=__builtin_amdgcn_mfma_f32_32x32x16_bf16(b0,qr[0],negm,0,0,0);p1=__builtin_amdgcn_mfma_f32_32x32x16_bf16(b1,qr[0],negm,0,0,0);}
    else{p0=__builtin_amdgcn_mfma_f32_32x32x16_bf16(b0,qr[d0],p0,0,0,0);p1=__builtin_amdgcn_mfma_f32_32x32x16_bf16(b1,qr[d0],p1,0,0,0);}}
}
typedef __attribute__((address_space(3))) const char* lds_cptr;
typedef short v4i16_t __attribute__((ext_vector_type(4)));
__device__ __forceinline__ void kload8(bf16x8*kf,lds_cptr kp){
  kf[0]=*(const __attribute__((address_space(3))) bf16x8*)(kp);      kf[1]=*(const __attribute__((address_space(3))) bf16x8*)(kp+512);
  kf[2]=*(const __attribute__((address_space(3))) bf16x8*)(kp+2048); kf[3]=*(const __attribute__((address_space(3))) bf16x8*)(kp+2560);
  kf[4]=*(const __attribute__((address_space(3))) bf16x8*)(kp+4096); kf[5]=*(const __attribute__((address_space(3))) bf16x8*)(kp+4608);
  kf[6]=*(const __attribute__((address_space(3))) bf16x8*)(kp+6144); kf[7]=*(const __attribute__((address_space(3))) bf16x8*)(kp+6656);
}
__device__ __forceinline__ void kload2(bf16x8*kf,lds_cptr kp,int j){ kf[2*j]=*(const __attribute__((address_space(3))) bf16x8*)(kp+j*2048); kf[2*j+1]=*(const __attribute__((address_space(3))) bf16x8*)(kp+j*2048+512); }
__device__ __forceinline__ s16x4 vtr(lds_cptr p){ return __builtin_bit_cast(s16x4,__builtin_amdgcn_ds_read_tr16_b64_v4i16((__attribute__((address_space(3))) v4i16_t*)p)); }
__device__ __forceinline__ float rowmax(const f32x16&p0,const f32x16&p1){
  float a=max3f(p0[0],p0[1],p1[0]),b=max3f(p0[2],p0[3],p1[1]);a=max3f(a,p1[2],p1[3]);
  #pragma unroll
  for(int r=4;r<16;r+=4){a=max3f(a,p0[r],p0[r+1]);b=max3f(b,p0[r+2],p0[r+3]);a=max3f(a,p1[r],p1[r+1]);b=max3f(b,p1[r+2],p1[r+3]);}
  const float m=max2f(a,b);
  auto rr=__builtin_amdgcn_permlane32_swap(__float_as_uint(m),__float_as_uint(m),false,false);
  return max2f(__uint_as_float(rr[0]),__uint_as_float(rr[1]));
}
__device__ __forceinline__ void pv(f32x16*o,int vb,bf16x8 pa0,bf16x8 pa1,bf16x8 pa2,bf16x8 pa3){
  #pragma unroll
  for(int d0=0;d0<2;++d0){s16x4 lo[4],hi[4];
    #pragma unroll
    for(int ks=0;ks<4;++ks){
      asm volatile("ds_read_b64_tr_b16 %0,%1 offset:%c2":"=&v"(lo[ks]):"v"(vb),"i"(d0*4096+ks*1024):"memory");
      asm volatile("ds_read_b64_tr_b16 %0,%1 offset:%c2":"=&v"(hi[ks]):"v"(vb),"i"(d0*4096+ks*1024+512):"memory");}
    asm volatile("s_waitcnt lgkmcnt(0)":::"memory");SBAR();
    #define PK(k) (bf16x8){lo[k][0],lo[k][1],lo[k][2],lo[k][3],hi[k][0],hi[k][1],hi[k][2],hi[k][3]}
    o[d0]=__builtin_amdgcn_mfma_f32_32x32x16_bf16(pa0,PK(0),o[d0],0,0,0);
    o[d0]=__builtin_amdgcn_mfma_f32_32x32x16_bf16(pa1,PK(1),o[d0],0,0,0);
    o[d0]=__builtin_amdgcn_mfma_f32_32x32x16_bf16(pa2,PK(2),o[d0],0,0,0);
    o[d0]=__builtin_amdgcn_mfma_f32_32x32x16_bf16(pa3,PK(3),o[d0],0,0,0);
    #undef PK
  }
}

constexpr int PITCH=2560, OPITCH=1792, LDS_RPB=LDS_BYTES;
struct AUnit { const bf16*q; const bf16*k; const bf16*v; bf16*o; float*lse; const float*rpb; int qs,ks,NT,p0,p1; };
template<int MODE> __device__ __forceinline__ void amask(f32x16&p0,f32x16&p1,int t,const AUnit&U,int wid,int r32,int hi,const float*rpbL){
  const float NEG=-INFINITY;
  if constexpr(MODE==2){
    const int base=64*t+4*hi-(U.p0+wid*32+r32);
    SBAR();
    #pragma unroll
    for(int r=0;r<16;++r){const int rel=base+(r&3)+8*(r>>2); if((unsigned)(rel+64)>128u)p0[r]=NEG; if((unsigned)(rel+96)>128u)p1[r]=NEG; if((r&3)==3)SBAR();}
  } else if constexpr(MODE==1){
    int r32l=r32; asm volatile("":"+v"(r32l));
    const int rq=U.p0+(wid>>1), cq=32*(wid&1)+r32l; const int r0=min(max(rq-4,0),56), c0=min(max(cq-8,0),48); const int kr=U.p1+t; int c0l=c0;
    { const bool rowok=(unsigned)(kr-r0)<8u; if(!rowok)c0l=1000;
      const float*bt=rpbL+(kr-rq+7)*31+(15-cq);
      #pragma unroll
      for(int r=0;r<16;r+=4){
        #pragma unroll
        for(int q=0;q<4;++q){const int kc=4*hi+((r+q)&3)+8*((r+q)>>2); const float b0=bt[kc]; p0[r+q]=((unsigned)(kc-c0l)<16u)?p0[r+q]+b0:NEG;}
        asm volatile("":"+v"(p0[r]),"+v"(p0[r+1]),"+v"(p0[r+2]),"+v"(p0[r+3]));
      }
      #pragma unroll
      for(int r=0;r<16;r+=4){
        #pragma unroll
        for(int q=0;q<4;++q){const int kc=32+4*hi+((r+q)&3)+8*((r+q)>>2); const float b1=bt[kc]; p1[r+q]=((unsigned)(kc-c0l)<16u)?p1[r+q]+b1:NEG;}
        asm volatile("":"+v"(p1[r]),"+v"(p1[r+1]),"+v"(p1[r+2]),"+v"(p1[r+3]));
      }
    }
  }
}
template<int THRL,int MODE> __device__ __forceinline__ void attn_unit(const AUnit&U,char*shm,int tid_in){
  const int tid=tid_in,lane=tid&63,r32=lane&31,hi=lane>>5; const int wid=__builtin_amdgcn_readfirstlane(tid>>6);
  const long qstep=(long)U.qs*PITCH, kstep_=(long)U.ks*PITCH; float*rpbL=(float*)(shm+LDS_RPB);
  const bf16*Qw=U.q+(long)(wid*QBLK)*qstep;
  const bf16*Kh=U.k,*Vh=U.v;
  const unsigned lds0=(unsigned)(uintptr_t)shm;
  float*wsf=(float*)(shm+LDS_WS)+wid*64;
  const bf16*ksrc=Kh+(long)lane*kstep_+wid*8;
  const bf16*vsrc=Vh+(long)(16*(wid&3)+(lane>>2))*kstep_+(wid>>2)*32+(lane&3)*8;
  const unsigned kdst=lds0+LDS_K+wid*1024, vdst=lds0+LDS_V+wid*1024;
  #define DMA_K(t,slot) glds16(ksrc+(long)(t)*KVBLK*kstep_,(unsigned)__builtin_amdgcn_readfirstlane(kdst+(slot)))
  #define DMA_V(t,slot) glds16(vsrc+(long)(t)*KVBLK*kstep_,(unsigned)__builtin_amdgcn_readfirstlane(vdst+(slot)))
  const int vb0=(int)(lds0+LDS_V)+((lane>>4)&1)*32+(lane&3)*8+(4*hi+((lane&15)>>2))*64;
  const char*Kbase=shm+LDS_K; bf16x8 kf[8];
  const lds_cptr shm3=(lds_cptr)shm; const lds_cptr kp0=shm3+LDS_K+hi*1024+r32*16; const lds_cptr vp0=shm3+LDS_V+((lane>>4)&1)*32+(lane&3)*8+(4*hi+((lane&15)>>2))*64;
  const int NT=U.NT;
  DMA_K(0,0);DMA_V(0,0);DMA_K(1,SLOTB);
  bf16x8 qr[4];
  #pragma unroll
  for(int d0=0;d0<4;++d0)qr[d0]=*reinterpret_cast<const bf16x8*>(&Qw[(long)r32*qstep+d0*16+hi*8]);
  float mhat=0.f,l_reg=0.f;f32x16 o[2];f32x16 negm; { float z_=0.f; asm volatile("":"+v"(z_)); _Pragma("unroll") for(int r=0;r<16;++r){o[0][r]=z_;o[1][r]=z_;negm[r]=z_;} } if constexpr(MODE!=1){asm volatile("":"+v"(negm));}
  const int qrel=wid*QBLK+r32;
  #define CMASK(P0,P1,t) amask<MODE>(P0,P1,(t),U,wid,r32,hi,rpbL)
  bool resc=false;
  #define START(P0,P1) do{ const float rm=rowmax(P0,P1); resc=false; \
    { const float dl=__builtin_fmaxf(rm,-30.f); mhat=fadd_s(mhat,dl); \
      _Pragma("unroll") for(int r=0;r<16;++r){P0[r]=fsub_s(P0[r],dl);P1[r]=fsub_s(P1[r],dl);} \
      if constexpr(MODE!=1){ _Pragma("unroll") for(int r=0;r<16;++r)negm[r]=-mhat; asm volatile("":"+v"(negm)); } } \
    _Pragma("unroll") for(int r=0;r<16;++r)P0[r]=__builtin_amdgcn_exp2f(P0[r]); }while(0)
  #define RESC() do{ if(resc){ asm volatile("s_waitcnt lgkmcnt(0)":::"memory"); \
      _Pragma("unroll") for(int d_=0;d_<2;++d_) _Pragma("unroll") for(int r=0;r<16;++r)o[d_][r]*=wsf[crow(r,hi)]; } }while(0)
  f32x16 pA0,pA1,pB0,pB1;
  int sl_prev=0,sl_cur=0,sl_next=SLOTB;
  #define ROT() do{sl_prev=sl_cur;sl_cur=sl_next;sl_next=(sl_next==(NSLOT-1)*SLOTB)?0:sl_next+SLOTB;}while(0)
  DMA_K(2,2*SLOTB);
  if constexpr(MODE==1){ for(int i_=tid;i_<465;i_+=512) rpbL[i_]=U.rpb[i_]*1.4426950408889634f; }
  WAIT_BAR(3);
  qkt(pA0,pA1,Kbase,qr,negm,r32,hi);asm volatile("s_nop 15\n\ts_nop 7":"+v"(pA0),"+v"(pA1));CMASK(pA0,pA1,0);
  START(pA0,pA1);
  _Pragma("unroll") for(int r=0;r<16;++r)pA1[r]=__builtin_amdgcn_exp2f(pA1[r]);
  WAIT_BAR(0);
  DMA_K(3,0);DMA_V(1,SLOTB);
  ROT();
  kload8(kf,kp0+sl_cur);
  WAIT_BAR(2);
  s16x4 vlo[8],vhi[8]; u32x4 pw0,pw1,pw2,pw3;
  #define PKW(P,B) cvtpk_s(P[B],P[B+1])
  #define PAF(k) __builtin_bit_cast(bf16x8,pw##k)
  #define VFR(i) (bf16x8){vlo[i][0],vlo[i][1],vlo[i][2],vlo[i][3],vhi[i][0],vhi[i][1],vhi[i][2],vhi[i][3]}
  #define PIN(x) asm volatile("":"+v"(x))
  #define MX3(a,b,c) __builtin_fmaxf(__builtin_fmaxf((a),(b)),(c))
  #define GAPA(MF,A0,A1,A2,A3,W0,W1,PW) do{ MF; sacc+=A0; sacc+=A1; sacc+=A2; sacc+=A3; PIN(sacc); W0; W1; PIN(PW); SBAR(); }while(0)
  #define EX(v) __builtin_amdgcn_exp2f(v)
  #define GAPB(MF,X,B) do{ MF; X[B]=EX(X[B]); X[B+1]=EX(X[B+1]); X[B+2]=EX(X[B+2]); X[B+3]=EX(X[B+3]); PIN(X); SBAR(); }while(0)
  #define VRD(i) do{ vlo[i]=vtr(vp_+(((i)>>2)*4096+((i)&3)*1024)); vhi[i]=vtr(vp_+(((i)>>2)*4096+((i)&3)*1024+512)); }while(0)
  #define KRD(G,j) do{ if(G){ kload2(kf,kp0+sl_next,j); SBAR(); } }while(0)
  #define STEP(C0,C1,P0,P1,t,GK,GV,GL) do{ SBAR(); \
    const lds_cptr vp_=vp0+sl_prev; \
    VRD(0); SBAR(); float sacc=(P0[0]+P0[1]); \
    if constexpr(MODE==1){ const float nm_=-mhat; _Pragma("unroll") for(int r=0;r<16;++r){C0[r]=nm_;C1[r]=nm_;} } \
    GAPA(C0=__builtin_amdgcn_mfma_f32_32x32x16_bf16(kf[0],qr[0],(MODE==1?C0:negm),0,0,0), P0[2],P0[3],P0[4],P0[5],     pw0[0]=PKW(P0,0), pw0[1]=PKW(P0,2), pw0); \
    VRD(4); SBAR(); GAPA(C1=__builtin_amdgcn_mfma_f32_32x32x16_bf16(kf[1],qr[0],(MODE==1?C1:negm),0,0,0), P0[6],P0[7],P0[8],P0[9],     pw0[2]=PKW(P0,4), pw0[3]=PKW(P0,6), pw0); \
    VRD(1); SBAR(); GAPA(C0=__builtin_amdgcn_mfma_f32_32x32x16_bf16(kf[2],qr[1],C0,0,0,0),   P0[10],P0[11],P0[12],P0[13], pw1[0]=PKW(P0,8), pw1[1]=PKW(P0,10), pw1); \
    VRD(5); SBAR(); GAPA(C1=__builtin_amdgcn_mfma_f32_32x32x16_bf16(kf[3],qr[1],C1,0,0,0),   P0[14],P0[15],P1[0],P1[1],   pw1[2]=PKW(P0,12),pw1[3]=PKW(P0,14), pw1); \
    VRD(2); SBAR(); GAPA(C0=__builtin_amdgcn_mfma_f32_32x32x16_bf16(kf[4],qr[2],C0,0,0,0),   P1[2],P1[3],P1[4],P1[5],     pw2[0]=PKW(P1,0), pw2[1]=PKW(P1,2), pw2); \
    VRD(6); SBAR(); GAPA(C1=__builtin_amdgcn_mfma_f32_32x32x16_bf16(kf[5],qr[2],C1,0,0,0),   P1[6],P1[7],P1[8],P1[9],     pw2[2]=PKW(P1,4), pw2[3]=PKW(P1,6), pw2); \
    VRD(3); SBAR(); GAPA(C0=__builtin_amdgcn_mfma_f32_32x32x16_bf16(kf[6],qr[3],C0,0,0,0),   P1[10],P1[11],P1[12],P1[13], pw3[0]=PKW(P1,8), pw3[1]=PKW(P1,10), pw3); \
    VRD(7); SBAR(); GAPA(C1=__builtin_amdgcn_mfma_f32_32x32x16_bf16(kf[7],qr[3],C1,0,0,0),   P1[14],P1[15],0.f,0.f,       pw3[2]=PKW(P1,12),pw3[3]=PKW(P1,14), pw3); \
    l_reg+=sacc; \
    if(GK){DMA_K((t)+3,sl_cur);} if(GV){DMA_V((t)+1,sl_next);} \
    CMASK(C0,C1,t); \
    { float a=MX3(C0[0],C0[1],C1[0]),b=MX3(C0[2],C0[3],C1[1]); a=MX3(a,C1[2],C1[3]); \
      _Pragma("unroll") for(int r=4;r<16;r+=4){a=MX3(a,C0[r],C0[r+1]);b=MX3(b,C0[r+2],C0[r+3]);a=MX3(a,C1[r],C1[r+1]);b=MX3(b,C1[r+2],C1[r+3]);} \
      float rm=__builtin_fmaxf(a,b); { auto rr=__builtin_amdgcn_permlane32_swap(__float_as_uint(rm),__float_as_uint(rm),false,false); rm=__builtin_fmaxf(__uint_as_float(rr[0]),__uint_as_float(rr[1])); } \
      resc=false; \
      if(__builtin_expect(__any(rm>(float)THRL),0)){ const float dl=__builtin_fmaxf(rm,0.f); mhat+=dl; \
        _Pragma("unroll") for(int r=0;r<16;++r){C0[r]-=dl;C1[r]-=dl;} \
        if constexpr(MODE!=1){ _Pragma("unroll") for(int r=0;r<16;++r)negm[r]=-mhat; asm volatile("":"+v"(negm)); } \
        const float f=__builtin_amdgcn_exp2f(-dl); l_reg*=f; if(hi==0)wsf[r32]=f; resc=true; } } \
    SBAR(); \
    GAPB(o[0]=__builtin_amdgcn_mfma_f32_32x32x16_bf16(PAF(0),VFR(0),o[0],0,0,0), C0,0); \
    GAPB(o[1]=__builtin_amdgcn_mfma_f32_32x32x16_bf16(PAF(0),VFR(4),o[1],0,0,0), C0,4); \
    KRD(GL,0); GAPB(o[0]=__builtin_amdgcn_mfma_f32_32x32x16_bf16(PAF(1),VFR(1),o[0],0,0,0), C0,8); \
    KRD(GL,1); GAPB(o[1]=__builtin_amdgcn_mfma_f32_32x32x16_bf16(PAF(1),VFR(5),o[1],0,0,0), C0,12); \
    KRD(GL,2); GAPB(o[0]=__builtin_amdgcn_mfma_f32_32x32x16_bf16(PAF(2),VFR(2),o[0],0,0,0), C1,0); \
    KRD(GL,3); GAPB(o[1]=__builtin_amdgcn_mfma_f32_32x32x16_bf16(PAF(2),VFR(6),o[1],0,0,0), C1,4); \
    GAPB(o[0]=__builtin_amdgcn_mfma_f32_32x32x16_bf16(PAF(3),VFR(3),o[0],0,0,0), C1,8); \
    GAPB(o[1]=__builtin_amdgcn_mfma_f32_32x32x16_bf16(PAF(3),VFR(7),o[1],0,0,0), C1,12); \
    }while(0)
  int t=1;
  for(;t+5<NT;t+=2){
    STEP(pB0,pB1,pA0,pA1,t,true,true,true);     WAIT_BAR(2); RESC(); ROT();
    STEP(pA0,pA1,pB0,pB1,t+1,true,true,true);   WAIT_BAR(2); RESC(); ROT();
  }
  #define ENDW(tt) do{ if((tt)+3<NT){WAIT_BAR(2);} else if((tt)+2<NT){WAIT_BAR(1);} else {WAIT_BAR(0);} }while(0)
  for(;t+1<NT;t+=2){
    STEP(pB0,pB1,pA0,pA1,t,(t+3<NT),(t+1<NT),(t+1<NT));       ENDW(t);   RESC(); ROT();
    STEP(pA0,pA1,pB0,pB1,t+1,(t+4<NT),(t+2<NT),(t+2<NT));     ENDW(t+1); RESC(); ROT();
  }
  STEP(pB0,pB1,pA0,pA1,NT-1,false,false,false); RESC();
  { float sacc=pB0[0]+pB0[1]; _Pragma("unroll") for(int r=2;r<16;++r)sacc+=pB0[r]; _Pragma("unroll") for(int r=0;r<16;++r)sacc+=pB1[r]; l_reg+=sacc;
    pw0=(u32x4){PKW(pB0,0),PKW(pB0,2),PKW(pB0,4),PKW(pB0,6)};pw1=(u32x4){PKW(pB0,8),PKW(pB0,10),PKW(pB0,12),PKW(pB0,14)};pw2=(u32x4){PKW(pB1,0),PKW(pB1,2),PKW(pB1,4),PKW(pB1,6)};pw3=(u32x4){PKW(pB1,8),PKW(pB1,10),PKW(pB1,12),PKW(pB1,14)};
    SBAR(); pv(o,vb0+sl_cur,PAF(0),PAF(1),PAF(2),PAF(3)); }
  #undef PKW
  #undef PAF
  #undef VFR
  #undef PIN
  #undef MX3
  #undef GAPA
  #undef GAPB
  #undef EX
  #undef VRD
  #undef KRD
  #undef STEP
  #undef ENDW
  int lane_e=lane; asm volatile("":"+v"(lane_e)); const int r32e=lane_e&31, hie=lane_e>>5;
  {auto rr=__builtin_amdgcn_permlane32_swap(__float_as_uint(l_reg),__float_as_uint(l_reg),false,false);l_reg=__uint_as_float(rr[0])+__uint_as_float(rr[1]);}
  if(hie==0)wsf[32+r32e]=l_reg;asm volatile("s_waitcnt lgkmcnt(0)":::"memory");
  float rli[16];
  #pragma unroll
  for(int r=0;r<16;++r)rli[r]=__builtin_amdgcn_rcpf(wsf[32+crow(r,hie)]);
  bf16*Ow=U.o+(long)(wid*QBLK)*U.qs*OPITCH; if(U.lse&&hie==0)U.lse[(long)(wid*QBLK+r32e)*U.qs*6]=mhat+__builtin_log2f(l_reg);
  { bf16*stg=(bf16*)(shm+LDS_OST)+wid*2048;
    #pragma unroll
    for(int r=0;r<16;++r){const int orow=crow(r,hie);
      #pragma unroll
      for(int d0=0;d0<2;++d0)stg[orow*64+d0*32+r32e]=__float2bfloat16(o[d0][r]*rli[r]);}
    asm volatile("s_waitcnt lgkmcnt(0)":::"memory");
    #pragma unroll
    for(int i=0;i<4;++i){const int row=i*8+(lane_e>>3),ch=lane_e&7; const u32x4 v=*(const u32x4*)(stg+row*64+ch*8); ATTN_STORE16(Ow+(long)row*U.qs*OPITCH+ch*8,v);} }
  asm volatile("s_waitcnt lgkmcnt(0)\n\ts_barrier":::"memory");
  #undef DMA_K
  #undef DMA_V
  #undef CMASK
  #undef START
  #undef RESC
  #undef ROT
}
template<int MODE> __device__ __forceinline__ void attn_unit_simple(const AUnit&U,char*shm,int tid_in){
  const int tid=tid_in,lane=tid&63,r32=lane&31,hi=lane>>5; const int wid=__builtin_amdgcn_readfirstlane(tid>>6);
  const long qstep=(long)U.qs*PITCH, kstep_=(long)U.ks*PITCH; float*rpbL=(float*)(shm+LDS_RPB);
  const bf16*Qw=U.q+(long)(wid*QBLK)*qstep;
  const unsigned lds0=(unsigned)(uintptr_t)shm;
  float*wsf=(float*)(shm+LDS_WS)+wid*64;
  const bf16*ksrc=U.k+(long)lane*kstep_+wid*8;
  const bf16*vsrc=U.v+(long)(16*(wid&3)+(lane>>2))*kstep_+(wid>>2)*32+(lane&3)*8;
  const unsigned kdst=lds0+LDS_K+wid*1024, vdst=lds0+LDS_V+wid*1024;
  const int vb0=(int)(lds0+LDS_V)+((lane>>4)&1)*32+(lane&3)*8+(4*hi+((lane&15)>>2))*64;
  const char*Kbase=shm+LDS_K;
  const int NT=U.NT;
  bf16x8 qr[4];
  #pragma unroll
  for(int d0=0;d0<4;++d0)qr[d0]=*reinterpret_cast<const bf16x8*>(&Qw[(long)r32*qstep+d0*16+hi*8]);
  if constexpr(MODE==1){ for(int i_=tid;i_<465;i_+=512) rpbL[i_]=U.rpb[i_]*1.4426950408889634f; }
  glds16(ksrc,(unsigned)__builtin_amdgcn_readfirstlane(kdst)); glds16(vsrc,(unsigned)__builtin_amdgcn_readfirstlane(vdst));
  if(NT>1){ glds16(ksrc+(long)KVBLK*kstep_,(unsigned)__builtin_amdgcn_readfirstlane(kdst+SLOTB)); glds16(vsrc+(long)KVBLK*kstep_,(unsigned)__builtin_amdgcn_readfirstlane(vdst+SLOTB)); }
  float mhat=-30.f,l_reg=0.f; f32x16 o[2]; f32x16 zc;
  { float z_=0.f; asm volatile("":"+v"(z_)); _Pragma("unroll") for(int r=0;r<16;++r){o[0][r]=z_;o[1][r]=z_;zc[r]=z_;} }
  int sl=0, sl2=2*SLOTB;
  for(int t=0;t<NT;++t){
    if(t+1<NT){ asm volatile("s_waitcnt vmcnt(2) lgkmcnt(0)\n\ts_barrier":::"memory"); } else { asm volatile("s_waitcnt vmcnt(0) lgkmcnt(0)\n\ts_barrier":::"memory"); }
    if(t+2<NT){ glds16(ksrc+(long)(t+2)*KVBLK*kstep_,(unsigned)__builtin_amdgcn_readfirstlane(kdst+sl2)); glds16(vsrc+(long)(t+2)*KVBLK*kstep_,(unsigned)__builtin_amdgcn_readfirstlane(vdst+sl2)); }
    f32x16 p0,p1; qkt(p0,p1,Kbase+sl,qr,zc,r32,hi); asm volatile("s_nop 15\n\ts_nop 7":"+v"(p0),"+v"(p1));
    amask<MODE>(p0,p1,t,U,wid,r32,hi,rpbL);
    const float rm=rowmax(p0,p1); const float mnew=__builtin_fmaxf(mhat,rm); const float f=__builtin_amdgcn_exp2f(mhat-mnew); mhat=mnew; l_reg*=f;
    if(hi==0)wsf[r32]=f; asm volatile("s_waitcnt lgkmcnt(0)":::"memory");
    #pragma unroll
    for(int d_=0;d_<2;++d_)
      #pragma unroll
      for(int r=0;r<16;++r)o[d_][r]*=wsf[crow(r,hi)];
    float sacc=0.f;
    #pragma unroll
    for(int r=0;r<16;++r){p0[r]=__builtin_amdgcn_exp2f(p0[r]-mnew);p1[r]=__builtin_amdgcn_exp2f(p1[r]-mnew);sacc+=p0[r]+p1[r];}
    l_reg+=sacc;
    #define PKW(P,B) cvtpk_s(P[B],P[B+1])
    const u32x4 pw0=(u32x4){PKW(p0,0),PKW(p0,2),PKW(p0,4),PKW(p0,6)},pw1=(u32x4){PKW(p0,8),PKW(p0,10),PKW(p0,12),PKW(p0,14)},pw2=(u32x4){PKW(p1,0),PKW(p1,2),PKW(p1,4),PKW(p1,6)},pw3=(u32x4){PKW(p1,8),PKW(p1,10),PKW(p1,12),PKW(p1,14)};
    #undef PKW
    asm volatile("s_waitcnt lgkmcnt(0)":::"memory");
    pv(o,vb0+sl,__builtin_bit_cast(bf16x8,pw0),__builtin_bit_cast(bf16x8,pw1),__builtin_bit_cast(bf16x8,pw2),__builtin_bit_cast(bf16x8,pw3));
    sl=(sl==2*SLOTB)?0:sl+SLOTB; sl2=(sl2==2*SLOTB)?0:sl2+SLOTB;
  }
  asm volatile("s_waitcnt lgkmcnt(0)\n\ts_barrier":::"memory");
  {auto rr=__builtin_amdgcn_permlane32_swap(__float_as_uint(l_reg),__float_as_uint(l_reg),false,false);l_reg=__uint_as_float(rr[0])+__uint_as_float(rr[1]);}
  if(hi==0)wsf[32+r32]=l_reg;asm volatile("s_waitcnt lgkmcnt(0)":::"memory");
  float rli[16];
  #pragma unroll
  for(int r=0;r<16;++r)rli[r]=__builtin_amdgcn_rcpf(wsf[32+crow(r,hi)]);
  bf16*Ow=U.o+(long)(wid*QBLK)*U.qs*OPITCH; if(U.lse&&hi==0)U.lse[(long)(wid*QBLK+r32)*U.qs*6]=mhat+__builtin_log2f(l_reg);
  { bf16*stg=(bf16*)(shm+LDS_OST)+wid*2048;
    #pragma unroll
    for(int r=0;r<16;++r){const int orow=crow(r,hi);
      #pragma unroll
      for(int d0=0;d0<2;++d0)stg[orow*64+d0*32+r32]=__float2bfloat16(o[d0][r]*rli[r]);}
    asm volatile("s_waitcnt lgkmcnt(0)":::"memory");
    #pragma unroll
    for(int i=0;i<4;++i){const int row=i*8+(lane>>3),ch=lane&7; const u32x4 v=*(const u32x4*)(stg+row*64+ch*8); ATTN_STORE16(Ow+(long)row*U.qs*OPITCH+ch*8,v);} }
  asm volatile("s_waitcnt lgkmcnt(0)\n\ts_barrier":::"memory");
}
template<int MODE> __device__ __forceinline__ void attn_wave(const AUnit&U,char*shm,int wid,int lane,float*wsf,const float*rpbL,int kbyte,int vbyte){
  const int r32=lane&31,hi=lane>>5;
  const long qstep=(long)U.qs*PITCH, kstep_=(long)U.ks*PITCH;
  const bf16*Qw=U.q+(long)(wid*QBLK)*qstep;
  int t0,t1;
  if constexpr(MODE==2){ const int lo_=U.p0+32*wid-64, hi_=U.p0+32*wid+95; t0=lo_<0?0:(lo_>>6); t1=hi_>>6; if(t1>U.NT-1)t1=U.NT-1; }
  else { const int rq=U.p0+(wid>>1); const int r0=min(max(rq-4,0),56); t0=r0-U.p1; t1=t0+7; }
  const unsigned lds0=(unsigned)(uintptr_t)shm;
  const bf16*ksrc=U.k+(long)lane*kstep_;
  const bf16*vsrc=U.v+(long)(lane>>2)*kstep_+(lane&3)*8;
  const int vb0=(int)(lds0+vbyte)+((lane>>4)&1)*32+(lane&3)*8+(4*hi+((lane&15)>>2))*64;
  bf16x8 qr[4];
  #pragma unroll
  for(int d0=0;d0<4;++d0)qr[d0]=*reinterpret_cast<const bf16x8*>(&Qw[(long)r32*qstep+d0*16+hi*8]);
  float mhat=-30.f,l_reg=0.f; f32x16 o[2]; f32x16 zc;
  { float z_=0.f; asm volatile("":"+v"(z_)); _Pragma("unroll") for(int r=0;r<16;++r){o[0][r]=z_;o[1][r]=z_;zc[r]=z_;} }
  for(int t=t0;t<=t1;++t){
    asm volatile("s_waitcnt lgkmcnt(0)":::"memory");
    const bf16*kt=ksrc+(long)t*KVBLK*kstep_; const bf16*vt=vsrc+(long)t*KVBLK*kstep_;
    #pragma unroll
    for(int c=0;c<8;++c) glds16(kt+c*8,(unsigned)__builtin_amdgcn_readfirstlane(lds0+kbyte+c*1024));
    #pragma unroll
    for(int p=0;p<8;++p) glds16(vt+(long)(16*(p&3))*kstep_+(p>>2)*32,(unsigned)__builtin_amdgcn_readfirstlane(lds0+vbyte+p*1024));
    asm volatile("s_waitcnt vmcnt(8)":::"memory");
    f32x16 p0,p1; qkt(p0,p1,shm+kbyte,qr,zc,r32,hi); asm volatile("s_nop 15\n\ts_nop 7":"+v"(p0),"+v"(p1));
    amask<MODE>(p0,p1,t,U,wid,r32,hi,rpbL);
    const float rm=rowmax(p0,p1); const float mnew=__builtin_fmaxf(mhat,rm); const float f=__builtin_amdgcn_exp2f(mhat-mnew); mhat=mnew; l_reg*=f;
    if(hi==0)wsf[r32]=f; asm volatile("s_waitcnt lgkmcnt(0)":::"memory");
    #pragma unroll
    for(int d_=0;d_<2;++d_)
      #pragma unroll
      for(int r=0;r<16;++r)o[d_][r]*=wsf[crow(r,hi)];
    float sacc=0.f;
    #pragma unroll
    for(int r=0;r<16;++r){p0[r]=__builtin_amdgcn_exp2f(p0[r]-mnew);p1[r]=__builtin_amdgcn_exp2f(p1[r]-mnew);sacc+=p0[r]+p1[r];}
    l_reg+=sacc;
    #define PKW(P,B) cvtpk_s(P[B],P[B+1])
    const u32x4 pw0=(u32x4){PKW(p0,0),PKW(p0,2),PKW(p0,4),PKW(p0,6)},pw1=(u32x4){PKW(p0,8),PKW(p0,10),PKW(p0,12),PKW(p0,14)},pw2=(u32x4){PKW(p1,0),PKW(p1,2),PKW(p1,4),PKW(p1,6)},pw3=(u32x4){PKW(p1,8),PKW(p1,10),PKW(p1,12),PKW(p1,14)};
    #undef PKW
    asm volatile("s_waitcnt vmcnt(0) lgkmcnt(0)":::"memory");
    pv(o,vb0,__builtin_bit_cast(bf16x8,pw0),__builtin_bit_cast(bf16x8,pw1),__builtin_bit_cast(bf16x8,pw2),__builtin_bit_cast(bf16x8,pw3));
  }
  asm volatile("s_waitcnt lgkmcnt(0)":::"memory");
  {auto rr=__builtin_amdgcn_permlane32_swap(__float_as_uint(l_reg),__float_as_uint(l_reg),false,false);l_reg=__uint_as_float(rr[0])+__uint_as_float(rr[1]);}
  if(hi==0)wsf[32+r32]=l_reg;asm volatile("s_waitcnt lgkmcnt(0)":::"memory");
  float rli[16];
  #pragma unroll
  for(int r=0;r<16;++r)rli[r]=__builtin_amdgcn_rcpf(wsf[32+crow(r,hi)]);
  bf16*Ow=U.o+(long)(wid*QBLK)*U.qs*OPITCH; if(U.lse&&hi==0)U.lse[(long)(wid*QBLK+r32)*U.qs*6]=mhat+__builtin_log2f(l_reg);
  { bf16*stg=(bf16*)(shm+kbyte);
    #pragma unroll
    for(int r=0;r<16;++r){const int orow=crow(r,hi);
      #pragma unroll
      for(int d0=0;d0<2;++d0)stg[orow*64+d0*32+r32]=__float2bfloat16(o[d0][r]*rli[r]);}
    asm volatile("s_waitcnt lgkmcnt(0)":::"memory");
    #pragma unroll
    for(int i=0;i<4;++i){const int row=i*8+(lane>>3),ch=lane&7; const u32x4 v=*(const u32x4*)(stg+row*64+ch*8); ATTN_STORE16(Ow+(long)row*U.qs*OPITCH+ch*8,v);} }
  asm volatile("s_waitcnt lgkmcnt(0)":::"memory");
}
#undef SBAR
#undef WAIT_BAR
}
namespace cg = cooperative_groups;
#define GAS __attribute__((address_space(1)))
#define LAS __attribute__((address_space(3)))
typedef unsigned v4u __attribute__((ext_vector_type(4)));
typedef float f32x4 __attribute__((ext_vector_type(4)));
constexpr int NWAVES = 8;
constexpr int RING_BYTES = 131072, HALO_OFF = RING_BYTES, XBST_OFF = RING_BYTES + 4096, LDS_TOTAL = RING_BYTES + 4096 + 64;
constexpr size_t WL_IN = 0, WL_OUT = 5 * MiB, WL_GU = 7 * MiB, WL_DN = 18 * MiB, WL_STRIDE = 24 * MiB;
static_assert(attn_body::LDS_RPB + 465 * 4 <= RING_BYTES, "attention scratch fits the ring region");

__device__ __forceinline__ unsigned pk2(float lo, float hi) { return pg8::cvt_pk_bf16(lo, hi); }
__device__ __forceinline__ int dmap_in(int oc) {
    const int hd = oc >> 6, c = oc & 63, pn = hd >> 2, wc = hd & 3; int bj, pos;
    const bool partial = (hd >= 12 && hd < 24), axial = (hd >= 30 && hd < 38);
    if (partial) { if (c < 8) { bj = 0; pos = c; } else if (c < 16) { bj = 1; pos = c - 8; } else if (c < 40) { bj = 0; pos = c - 8; } else { bj = 1; pos = c - 32; } }
    else if (axial) { if (c < 16) { bj = 0; pos = c; } else if (c < 32) { bj = 1; pos = c - 16; } else if (c < 48) { bj = 0; pos = c - 16; } else { bj = 1; pos = c - 32; } }
    else { bj = c >> 5; pos = c & 31; }
    return pn * 256 + bj * 128 + wc * 32 + pos;
}
__device__ __forceinline__ int dmap_gu(int oc) { const int bj = oc >= DFF ? 1 : 0, ch = oc - bj * DFF; return (ch >> 7) * 256 + bj * 128 + (ch & 127); }
template <int MAP> __device__ __forceinline__ void p0_item(const float* W, const float* gk, int K, int N, bf16_t* WT, LAS float* scr, int item, int lane) {
    const int nblk = N / 32, kb = item / nblk, nb = item % nblk, k0 = 64 * kb, n0 = 32 * nb;
    {
        float4 wv[8];
#pragma unroll
        for (int i = 0; i < 8; ++i) wv[i] = *(const float4*)(W + (size_t)(k0 + 8 * i + (lane >> 3)) * N + n0 + (lane & 7) * 4);
#pragma unroll
        for (int i = 0; i < 8; ++i) { const int kk = 8 * i + (lane >> 3); const float g_ = gk ? gk[k0 + kk] : 1.f; LAS float* d = scr + kk * 33 + (lane & 7) * 4;
            d[0] = wv[i].x * g_; d[1] = wv[i].y * g_; d[2] = wv[i].z * g_; d[3] = wv[i].w * g_; }
    }
    asm volatile("s_waitcnt lgkmcnt(0)" ::: "memory");
    const int c = lane & 7;
#pragma unroll
    for (int j = 0; j < 4; ++j) { const int n = (lane >> 3) + 8 * j; const LAS float* s = scr + (8 * c) * 33 + n;
        v4u o; o.x = pk2(s[0 * 33], s[1 * 33]); o.y = pk2(s[2 * 33], s[3 * 33]); o.z = pk2(s[4 * 33], s[5 * 33]); o.w = pk2(s[6 * 33], s[7 * 33]);
        const int oc = n0 + n, dr = MAP == 1 ? dmap_in(oc) : MAP == 2 ? dmap_gu(oc) : oc;
        *(v4u*)(WT + (size_t)dr * K + k0 + 8 * c) = o; }
    asm volatile("s_waitcnt lgkmcnt(0)" ::: "memory");
}
template <int CTRL> __device__ __forceinline__ float dppf(float v) { return __uint_as_float((unsigned)__builtin_amdgcn_update_dpp(0, (int)__float_as_uint(v), CTRL, 0xf, 0xf, false)); }
__device__ __forceinline__ float wave_sum2(float v) {
    v += dppf<0xB1>(v); v += dppf<0x4E>(v); v += dppf<0x141>(v); v += dppf<0x140>(v);
    return pg8::quad_row_sum(v);
}
__device__ __forceinline__ void prep_row(const float* xrow, bf16_t* xbrow, float* ssprow, int lane) {
    const float4* xr = (const float4*)xrow; float ss = 0.f;
#pragma unroll
    for (int j = 0; j < 4; ++j) { const float4 v = xr[lane + 64 * j]; ss += (v.x * v.x + v.y * v.y) + (v.z * v.z + v.w * v.w);
        uint2 o; o.x = pk2(v.x, v.y); o.y = pk2(v.z, v.w); *(uint2*)(xbrow + (lane + 64 * j) * 4) = o; }
    ss = wave_sum2(ss);
    if (lane < 16) ssprow[lane] = lane == 0 ? ss : 0.f;
}
__device__ __forceinline__ void unpack8(const uint4 v, float (&f)[8]) {
    f[0] = __uint_as_float(v.x << 16); f[1] = __uint_as_float(v.x & 0xffff0000u); f[2] = __uint_as_float(v.y << 16); f[3] = __uint_as_float(v.y & 0xffff0000u);
    f[4] = __uint_as_float(v.z << 16); f[5] = __uint_as_float(v.z & 0xffff0000u); f[6] = __uint_as_float(v.w << 16); f[7] = __uint_as_float(v.w & 0xffff0000u);
}
__device__ __forceinline__ void mixfin_row(const bf16_t* ob, const float* lse, int row, const float* og, bf16_t* mo, int lane) {
    const int c8 = lane * 8, hd = lane >> 3; const bool a_on = lane < 32, s_on = lane < 48;
    const uint4 z4 = make_uint4(0u, 0u, 0u, 0u);
    const uint4 ua = a_on ? *(const uint4*)(ob + c8) : z4;
    const uint4 u0 = s_on ? *(const uint4*)(ob + 256 + c8) : z4, u1 = s_on ? *(const uint4*)(ob + 1024 + c8) : z4, u2 = s_on ? *(const uint4*)(ob + 1408 + c8) : z4, uc = s_on ? *(const uint4*)(ob + 640 + c8) : z4;
    const float l0 = s_on ? lse[((size_t)0 * M + row) * 6 + hd] : 0.f, l1 = s_on ? lse[((size_t)1 * M + row) * 6 + hd] : 0.f, l2 = s_on ? lse[((size_t)2 * M + row) * 6 + hd] : 0.f;
    float ga[8], gd[8], gc[8];
    { const float4 t0 = a_on ? *(const float4*)(og + c8) : make_float4(0, 0, 0, 0), t1 = a_on ? *(const float4*)(og + c8 + 4) : make_float4(0, 0, 0, 0);
      ga[0] = t0.x; ga[1] = t0.y; ga[2] = t0.z; ga[3] = t0.w; ga[4] = t1.x; ga[5] = t1.y; ga[6] = t1.z; ga[7] = t1.w; }
    { const float4 t0 = s_on ? *(const float4*)(og + 256 + c8) : make_float4(0, 0, 0, 0), t1 = s_on ? *(const float4*)(og + 256 + c8 + 4) : make_float4(0, 0, 0, 0);
      gd[0] = t0.x; gd[1] = t0.y; gd[2] = t0.z; gd[3] = t0.w; gd[4] = t1.x; gd[5] = t1.y; gd[6] = t1.z; gd[7] = t1.w; }
    { const float4 t0 = s_on ? *(const float4*)(og + 640 + c8) : make_float4(0, 0, 0, 0), t1 = s_on ? *(const float4*)(og + 640 + c8 + 4) : make_float4(0, 0, 0, 0);
      gc[0] = t0.x; gc[1] = t0.y; gc[2] = t0.z; gc[3] = t0.w; gc[4] = t1.x; gc[5] = t1.y; gc[6] = t1.z; gc[7] = t1.w; }
    float fa[8], f0[8], f1[8], f2[8], fc[8];
    unpack8(ua, fa); unpack8(u0, f0); unpack8(u1, f1); unpack8(u2, f2); unpack8(uc, fc);
    const float mx = fmaxf(l0, fmaxf(l1, l2)); const float w0 = exp2f(l0 - mx), w1 = exp2f(l1 - mx), w2 = exp2f(l2 - mx); const float iw = 1.f / (w0 + w1 + w2);
    float sa = 0.f, sd = 0.f, sc = 0.f;
#pragma unroll
    for (int i = 0; i < 8; ++i) { f0[i] = (w0 * f0[i] + w1 * f1[i] + w2 * f2[i]) * iw; sa += fa[i] * fa[i]; sd += f0[i] * f0[i]; sc += fc[i] * fc[i]; }
    sa = wave_sum2(sa); sd = wave_sum2(sd); sc = wave_sum2(sc);
    const float ra = rsqrtf(sa * (1.f / 256.f) + EPS), rd = rsqrtf(sd * (1.f / 384.f) + EPS), rc = rsqrtf(sc * (1.f / 384.f) + EPS);
    if (a_on) { uint4 o; o.x = pk2(fa[0] * ra * ga[0], fa[1] * ra * ga[1]); o.y = pk2(fa[2] * ra * ga[2], fa[3] * ra * ga[3]); o.z = pk2(fa[4] * ra * ga[4], fa[5] * ra * ga[5]); o.w = pk2(fa[6] * ra * ga[6], fa[7] * ra * ga[7]); *(uint4*)(mo + c8) = o; }
    if (s_on) { uint4 o; o.x = pk2(f0[0] * rd * gd[0], f0[1] * rd * gd[1]); o.y = pk2(f0[2] * rd * gd[2], f0[3] * rd * gd[3]); o.z = pk2(f0[4] * rd * gd[4], f0[5] * rd * gd[5]); o.w = pk2(f0[6] * rd * gd[6], f0[7] * rd * gd[7]); *(uint4*)(mo + 256 + c8) = o;
                uint4 p; p.x = pk2(fc[0] * rc * gc[0], fc[1] * rc * gc[1]); p.y = pk2(fc[2] * rc * gc[2], fc[3] * rc * gc[3]); p.z = pk2(fc[4] * rc * gc[4], fc[5] * rc * gc[5]); p.w = pk2(fc[6] * rc * gc[6], fc[7] * rc * gc[7]); *(uint4*)(mo + 640 + c8) = p; }
}
#define RLX_AGENT __ATOMIC_RELAXED, __HIP_MEMORY_SCOPE_AGENT
#define XB_TMO      128
#define XB_XCNT(j)  (256  + 64 * (j))
#define XB_XSUB(j)  (1280 + 64 * (j))
#define XB_XGEN(j)  (2304 + 64 * (j))
#define XB_TOP      3328
#define XB_TOPGEN   3392
#define XCD_BAR_WORDS 3456
#define XB_SPIN_CAP (1u << 18)

__device__ __forceinline__ unsigned xb_ld(unsigned* p)              { return __hip_atomic_load(p, __ATOMIC_RELAXED, __HIP_MEMORY_SCOPE_AGENT); }
__device__ __forceinline__ unsigned xb_add(unsigned* p, unsigned v) { return __hip_atomic_fetch_add(p, v, __ATOMIC_RELAXED, __HIP_MEMORY_SCOPE_AGENT); }
__device__ __forceinline__ unsigned xb_xcc_id() { return (unsigned)__builtin_amdgcn_s_getreg((3 << 11) | 20) & 0xFu; }
#define XB_SPIN(cond, bar) do { unsigned _sp = 0; while (cond) { __builtin_amdgcn_s_sleep(1); \
    if ((++_sp & 255u) == 0u) { if (xb_ld(&(bar)[XB_TMO])) break; if (_sp > XB_SPIN_CAP) { atomicAdd(&(bar)[XB_TMO], 1u); break; } } } } while (0)

struct XcdBarrier {
    unsigned* bar; unsigned x;
    volatile LAS unsigned* st;
};

__device__ __forceinline__ XcdBarrier xcd_barrier_post(unsigned* bar, volatile LAS unsigned* st) {
    XcdBarrier b; b.bar = bar; b.x = xb_xcc_id(); b.st = st;
    if (threadIdx.x == 0) (void)xb_add(&bar[XB_XCNT(b.x)], 1u);
    return b;
}
__device__ __forceinline__ void xcd_barrier_complete(unsigned* bar, unsigned x, unsigned& nloc, unsigned& nx) {
    const unsigned G = gridDim.x * gridDim.y * gridDim.z;
    unsigned sum, cnt, mine, sp = 0u;
    for (;;) {
        sum = 0u; cnt = 0u; mine = 0u;
#pragma unroll
        for (unsigned j = 0; j < 16; ++j) { const unsigned c = xb_ld(&bar[XB_XCNT(j)]); sum += c; cnt += (c > 0u) ? 1u : 0u; mine = (j == x) ? c : mine; }
        if (sum == G) break;
        __builtin_amdgcn_s_sleep(1);
        if ((++sp & 255u) == 0u) { if (xb_ld(&bar[XB_TMO])) break; if (sp > XB_SPIN_CAP) { atomicAdd(&bar[XB_TMO], 1u); break; } }
    }
    nloc = mine > 0u ? mine : 1u; nx = cnt > 0u ? cnt : 1u;
}

__device__ __forceinline__ void xcd_barrier(const XcdBarrier& b, int tid_b) {
    asm volatile("s_waitcnt vmcnt(0)" ::: "memory");
    __syncthreads();
    if (tid_b == 0) {
        unsigned* bar = b.bar;
        __builtin_amdgcn_s_waitcnt(0);
        unsigned nloc = b.st[0], nx = b.st[1];
        if (nloc == 0u) { xcd_barrier_complete(bar, b.x, nloc, nx); b.st[0] = nloc; b.st[1] = nx; }
        const unsigned old = xb_add(&bar[XB_XSUB(b.x)], 1u);
        const unsigned gen = old / nloc;
        if (old + 1u == (gen + 1u) * nloc) {
            __builtin_amdgcn_fence(__ATOMIC_RELEASE, "agent");
            asm volatile("s_waitcnt vmcnt(0)" ::: "memory");
            const unsigned og = xb_add(&bar[XB_TOP], 1u);
            const unsigned tg = og / nx;
            if (og + 1u == (tg + 1u) * nx) xb_add(&bar[XB_TOPGEN], 1u);
            else XB_SPIN(xb_ld(&bar[XB_TOPGEN]) == tg, bar);
            __builtin_amdgcn_fence(__ATOMIC_ACQUIRE, "agent");
            xb_add(&bar[XB_XGEN(b.x)], 1u);
            asm volatile("s_waitcnt vmcnt(0)" ::: "memory");
        } else {
            XB_SPIN(xb_ld(&bar[XB_XGEN(b.x)]) == gen, bar);
            __builtin_amdgcn_fence(__ATOMIC_ACQUIRE, "agent");
            asm volatile("s_waitcnt vmcnt(0)" ::: "memory");
        }
    }
    __syncthreads();
}

#ifndef NMAJ_P1
#define NMAJ_P1 0
#endif
#ifndef NMAJ_P5
#define NMAJ_P5 0
#endif
#ifndef WGM_P1
#define WGM_P1 2
#endif
#ifndef WGM_RES
#define WGM_RES 2
#endif
#ifndef WGM_P5
#define WGM_P5 2
#endif
#ifndef ALIGN_P1
#define ALIGN_P1 true
#endif
#ifndef ALIGN_RES
#define ALIGN_RES true
#endif
#ifndef THRL_GQA
#define THRL_GQA 8
#endif
#ifndef REP_P1
#define REP_P1 1
#endif
#ifndef REP_GQA
#define REP_GQA 1
#endif
#ifndef REP_NA
#define REP_NA 1
#endif
#ifndef REP_DIL
#define REP_DIL 1
#endif
#ifndef REP_P3
#define REP_P3 1
#endif
#ifndef REP_P5
#define REP_P5 1
#endif
#ifndef CHEAP_P5
#define CHEAP_P5 0
#endif
#ifndef REP_SYNC
#define REP_SYNC 1
#endif
struct Args { const float* in[13]; float* out; unsigned char* ws; int ph_lo, ph_hi; };
__device__ __forceinline__ int phase_tid(int wave_s) {
    unsigned ones = ~0u; asm volatile("" : "+s"(ones));
    const int lane = (int)__builtin_amdgcn_mbcnt_hi(ones, __builtin_amdgcn_mbcnt_lo(ones, 0u));
    return wave_s * 64 + lane;
}
typedef __attribute__((address_space(4))) const Args* cargs_t;
__device__ __forceinline__ cargs_t launder_args() { cargs_t p = (cargs_t)__builtin_amdgcn_kernarg_segment_ptr(); asm volatile("" : "+s"(p)); return p; }
#ifndef FWD_ALIGN
#define FWD_ALIGN 256
#endif
__global__ void __launch_bounds__(NWAVES * 64, 2) __attribute__((aligned(FWD_ALIGN))) fwd(Args args) {
    extern __shared__ __attribute__((aligned(16))) unsigned char lds[];
    cg::grid_group grid = cg::this_grid();
    const int G = gridDim.x, bx = blockIdx.x, vcu = (G % 8 == 0) ? (bx % 8) * (G / 8) + bx / 8 : bx;
#define GIN(i) ((const float*)(GAS const float*)AP->in[i])
#define PHASE_ARGS cargs_t AP = launder_args(); unsigned char* ws = (unsigned char*)(GAS unsigned char*)AP->ws; float* out = (float*)(GAS float*)AP->out; const float* x = GIN(0); (void)out; (void)x; \
    f32x2v_t* rot1 = (f32x2v_t*)(ws + WS_TAB); f32x2v_t* rotax = rot1 + 4096 * 8; (void)rotax; float* ssp = (float*)(ws + WS_SSP); float* lse = (float*)(ws + WS_LSE); (void)ssp; (void)lse; \
    bf16_t* XB = (bf16_t*)(ws + WS_XB); bf16_t* PROJ = (bf16_t*)(ws + WS_PROJ); bf16_t* OBUF = (bf16_t*)(ws + WS_OBUF); bf16_t* MIX = (bf16_t*)(ws + WS_MIX); bf16_t* ACT = (bf16_t*)(ws + WS_ACT); \
    (void)XB; (void)PROJ; (void)OBUF; (void)MIX; (void)ACT; unsigned char* wb = ws + WS_W + l * WL_STRIDE; (void)wb; \
    const int tid = phase_tid(wave_s), lane = tid & 63, wave = __builtin_amdgcn_readfirstlane(tid >> 6), gw = vcu * NWAVES + wave; (void)lane; (void)gw;
    const int lo = args.ph_lo, hi = args.ph_hi;
    if (threadIdx.x < 16) ((LAS unsigned*)((LAS unsigned char*)lds + XBST_OFF))[threadIdx.x] = 0u;
    int wave_s = __builtin_amdgcn_readfirstlane((int)(threadIdx.x >> 6)); asm volatile("" : "+s"(wave_s));
    __syncthreads();
    if (lo == 0 && hi > 2 && blockIdx.x == 0) { cargs_t AP0 = launder_args(); unsigned* bw = (unsigned*)((GAS unsigned char*)AP0->ws + WS_CTL); for (int i = threadIdx.x; i < XCD_BAR_WORDS; i += NWAVES * 64) bw[i] = 0u; }
#define IN(k) (lo <= (k) && (k) < hi)
#define SEAM(k) do { if (IN(k) && IN((k) + 1)) { for (int rs_ = 0; rs_ < REP_SYNC; ++rs_) { if ((k) == 0) { grid.sync(); cargs_t APc = launder_args(); (void)xcd_barrier_post((unsigned*)((GAS unsigned char*)APc->ws + WS_CTL), (volatile LAS unsigned*)((LAS unsigned char*)lds + XBST_OFF)); } else { cargs_t AP_ = launder_args(); XcdBarrier xb_; xb_.bar = (unsigned*)((GAS unsigned char*)AP_->ws + WS_CTL); xb_.x = xb_xcc_id(); xb_.st = (volatile LAS unsigned*)((LAS unsigned char*)lds + XBST_OFF); xcd_barrier(xb_, phase_tid(wave_s)); } } } } while (0)
    const int NGW = G * NWAVES;
    if (IN(0)) { const int l = 0; PHASE_ARGS
        LAS float* scr = (LAS float*)((LAS unsigned char*)lds + wave * 16384);
        constexpr int I_IN = 16 * 80, I_OUT = 16 * 32, I_GU = 16 * 176, I_DN = 44 * 32, I_L = I_IN + I_OUT + I_GU + I_DN;
        for (int it = gw; it < 2 * I_L; it += NGW) {
            const int l = it / I_L; int r = it % I_L; unsigned char* wb2 = ws + WS_W + l * WL_STRIDE;
            if (r < I_IN) { p0_item<1>(GIN(2) + (size_t)l * DM * DIN, GIN(1) + l * DM, DM, DIN, (bf16_t*)(wb2 + WL_IN), scr, r, lane); continue; } r -= I_IN;
            if (r < I_OUT) { p0_item<0>(GIN(7) + (size_t)l * DM * DM, nullptr, DM, DM, (bf16_t*)(wb2 + WL_OUT), scr, r, lane); continue; } r -= I_OUT;
            if (r < I_GU) { p0_item<2>(GIN(9) + (size_t)l * DM * 2 * DFF, GIN(8) + l * DM, DM, 2 * DFF, (bf16_t*)(wb2 + WL_GU), scr, r, lane); continue; } r -= I_GU;
            p0_item<0>(GIN(12) + (size_t)l * DFF * DM, nullptr, DFF, DM, (bf16_t*)(wb2 + WL_DN), scr, r, lane);
        }
        for (int i = bx * 512 + tid; i < 4096 * 8; i += G * 512) { const float2 cs = sincos_d((double)(i >> 3) * INV1[i & 7]); rot1[i] = (f32x2v_t){cs.x, cs.y}; }
        for (int i = bx * 512 + tid; i < 64 * 16; i += G * 512) { const float2 cs = sincos_d((double)(i >> 4) * INV2[i & 15]); rotax[i] = (f32x2v_t){cs.x, cs.y}; }
        for (int m = gw; m < M; m += 2 * NGW) { prep_row(x + (size_t)m * DM, XB + (size_t)m * DM, ssp + (size_t)m * 16, lane); prep_row(x + (size_t)(m + NGW) * DM, XB + (size_t)(m + NGW) * DM, ssp + (size_t)(m + NGW) * 16, lane); }
        __syncthreads();
    }
    SEAM(0);
    for (int l = 0; l < 2; ++l) {
        const int pb = 1 + 6 * l;
#ifndef SKIP_P1
        if (IN(pb)) { PHASE_ARGS
            pg8::Gemm g{XB, (const bf16_t*)(wb + WL_IN), M, DIN, DM, 256, 0}; pg8::StaticOrder S; S.init(M, DIN, G, bx);
            pg8::EpiIn E{PROJ, ssp, GIN(3) + l * 192, GIN(4) + l * 192, (const pg8::f32x2v*)rot1, (const pg8::f32x2v*)rotax};
            for (int rep = 0; rep < REP_P1; ++rep) pg8::gemm_phase<pg8::EpiIn, pg8::StaticOrder, ALIGN_P1, true>((LAS unsigned char*)lds, g, S, E, tid);
        }
#endif
        SEAM(pb);
#ifndef SKIP_P2
        if (IN(pb + 1)) { PHASE_ARGS
            using namespace attn_body;
            const bf16* P = (const bf16*)PROJ; bf16* O = (bf16*)OBUF;
#ifndef SKIP_GQA
            const int tid_GQA = phase_tid(wave_s);
            for (int rep = 0; rep < REP_GQA; ++rep) for (int id = vcu; id < 768; id += G) {
                const int qb = id & 15, g3 = (id >> 4) % 3, bk = id / 48, b = bk >> 1, kvh = bk & 1, h = kvh * 3 + g3;
                AUnit U; U.q = P + ((size_t)b * SEQ + 256 * qb) * PITCH + 1920 + h * 64; U.k = P + (size_t)b * SEQ * PITCH + 2304 + kvh * 64; U.v = P + (size_t)b * SEQ * PITCH + 2432 + kvh * 64;
                U.o = O + ((size_t)b * SEQ + 256 * qb) * OPITCH + 640 + h * 64; U.lse = nullptr; U.rpb = nullptr; U.qs = 1; U.ks = 1; U.NT = 64; U.p0 = 0; U.p1 = 0;
                attn_unit<THRL_GQA, 0>(U, (char*)lds, tid_GQA);
            }
#endif
#ifndef SKIP_NA
            const int tid_NA = phase_tid(wave_s);
            for (int rep = 0; rep < REP_NA; ++rep) for (int id = vcu; id < 512; id += G) {
                const int u4 = id & 15, h = (id >> 4) & 3, b = id >> 6, R = 4 * u4; const int kr0 = min(max(R - 4, 0), 56), last = min(max(R - 1, 0), 56) + 7; int nt = last - kr0 + 1; nt += nt & 1;
                AUnit U; U.q = P + ((size_t)b * SEQ + 256 * u4) * PITCH + h * 64; U.k = P + ((size_t)b * SEQ + 64 * kr0) * PITCH + 256 + h * 64; U.v = P + ((size_t)b * SEQ + 64 * kr0) * PITCH + 512 + h * 64;
                U.o = O + ((size_t)b * SEQ + 256 * u4) * OPITCH + h * 64; U.lse = nullptr; U.rpb = GIN(5) + (l * 4 + h) * 465; U.qs = 1; U.ks = 1; U.NT = nt; U.p0 = R; U.p1 = kr0;
                attn_unit<8, 1>(U, (char*)lds, phase_tid(wave_s));
            }
#endif
#ifndef SKIP_DIL
            const int tid_DIL = phase_tid(wave_s);
            for (int rep = 0; rep < REP_DIL; ++rep) for (int id = vcu; id < 2304; id += G) {
                int pat, rem; if (id < 768) { pat = 0; rem = id; } else if (id < 1536) { pat = 1; rem = id - 768; } else { pat = 2; rem = id - 1536; }
                const int d = pat == 0 ? 1 : pat == 1 ? 4 : 16, L = SEQ / d, nqb = L / 256;
                const int sub = rem & 15, bh = rem >> 4, h = bh % 6, b = bh / 6; const int res = sub / nqb, qb = sub % nqb;
                int kt0, nt; if (L == 256) { kt0 = 0; nt = 4; } else { kt0 = min(max(4 * qb - 1, 0), L / 64 - 6); nt = 6; }
                const size_t qtok = (size_t)b * SEQ + res + (size_t)d * 256 * qb, ktok = (size_t)b * SEQ + res + (size_t)d * 64 * kt0;
                AUnit U; U.q = P + qtok * PITCH + 768 + h * 64; U.k = P + ktok * PITCH + 1152 + h * 64; U.v = P + ktok * PITCH + 1536 + h * 64;
                U.o = O + qtok * OPITCH + (pat == 0 ? 256 : pat == 1 ? 1024 : 1408) + h * 64; U.lse = lse + ((size_t)pat * M + qtok) * 6 + h; U.rpb = nullptr; U.qs = d; U.ks = d; U.NT = nt; U.p0 = 256 * qb - 64 * kt0; U.p1 = 0;
                attn_unit<8, 2>(U, (char*)lds, tid_DIL);
            }
#endif
        }
#endif
        SEAM(pb + 1);
        if (IN(pb + 2)) { PHASE_ARGS for (int rep = 0; rep < REP_P3; ++rep) for (int m = gw; m < M; m += 2 * NGW) { mixfin_row(OBUF + (size_t)m * OB_LD, lse, m, GIN(6) + l * DM, MIX + (size_t)m * DM, lane); mixfin_row(OBUF + (size_t)(m + NGW) * OB_LD, lse, m + NGW, GIN(6) + l * DM, MIX + (size_t)(m + NGW) * DM, lane); } __syncthreads(); }
        SEAM(pb + 2);
#ifndef SKIP_P4
        if (IN(pb + 3)) { PHASE_ARGS
            pg8::Gemm g{MIX, (const bf16_t*)(wb + WL_OUT), M, DM, DM, 256, 0}; pg8::StaticOrder S; S.init(M, DM, G, bx);
            pg8::EpiRes E{l == 0 ? x : out, out, XB, ssp};
            pg8::gemm_phase<pg8::EpiRes, pg8::StaticOrder, ALIGN_RES, true>((LAS unsigned char*)lds, g, S, E, tid);
        }
#endif
        SEAM(pb + 3);
#ifndef SKIP_P5
        if (IN(pb + 4)) { PHASE_ARGS
            pg8::Gemm g{XB, (const bf16_t*)(wb + WL_GU), M, 2 * DFF, DM, 254, -1}; pg8::StaticOrder S; S.init2(130, 22, G, bx);
            pg8::EpiGateConv E{ACT, ssp, GIN(10) + l * 3 * DFF, GIN(11) + l * DFF, (LAS float*)((LAS unsigned char*)lds + HALO_OFF), 0};
            for (int rep = 0; rep < REP_P5; ++rep) { E.cheap = (rep + 1 < REP_P5) ? CHEAP_P5 : 0; pg8::gemm_phase<pg8::EpiGateConv, pg8::StaticOrder, true, true>((LAS unsigned char*)lds, g, S, E, tid); }
        }
#endif
        SEAM(pb + 4);
#ifndef SKIP_P6
        if (IN(pb + 5)) { PHASE_ARGS
            pg8::Gemm g{ACT, (const bf16_t*)(wb + WL_DN), M, DM, DFF, 256, 0}; pg8::StaticOrder S; S.init(M, DM, G, bx);
            pg8::EpiRes E{out, out, l == 0 ? XB : nullptr, l == 0 ? ssp : nullptr};
            pg8::gemm_phase<pg8::EpiRes, pg8::StaticOrder, ALIGN_RES, true>((LAS unsigned char*)lds, g, S, E, tid);
        }
#endif
        if (l == 0) SEAM(pb + 5);
    }
#undef IN
#undef SEAM
}


#ifndef DBG_FAST
#define DBG_FAST -1
#endif
extern "C" void kernel_launch(void* const* d_in, const int* in_sizes, int n_in, void* d_out, int out_size, void* d_ws, size_t ws_size, hipStream_t stream) {
    static int grid = 0;
    if (grid == 0) {
        int dev = 0, cus = 0, per_cu = 0;
        (void)hipGetDevice(&dev); (void)hipDeviceGetAttribute(&cus, hipDeviceAttributeMultiprocessorCount, dev);
        (void)hipFuncSetAttribute((const void*)fwd, hipFuncAttributeMaxDynamicSharedMemorySize, LDS_TOTAL);
        (void)hipOccupancyMaxActiveBlocksPerMultiprocessor(&per_cu, (const void*)fwd, NWAVES * 64, LDS_TOTAL);
        if (per_cu < 1) { fprintf(stderr, "kernel_launch: occupancy query says %d blocks per CU\n", per_cu); per_cu = 1; }
        grid = cus * 1;
    }
#if DBG_FAST >= 0
    (void)hipMemsetAsync((char*)d_ws + WS_CTL, 0, 16384, stream);
#endif
    Args a{};
    for (int i = 0; i < 13; ++i) a.in[i] = (const float*)d_in[i];
    a.out = (float*)d_out; a.ws = (unsigned char*)d_ws;
#if DBG_FAST < 0
    a.ph_lo = 0; a.ph_hi = 13;
    void* kargs[] = {&a};
    hipError_t e = hipLaunchCooperativeKernel((const void*)fwd, dim3(grid), dim3(NWAVES * 64), kargs, LDS_TOTAL, stream);
    if (e != hipSuccess) fprintf(stderr, "cooperative launch failed: %s (grid %d)\n", hipGetErrorString(e), grid);
#else
    const float* x = (const float*)d_in[0]; const float* n1 = (const float*)d_in[1]; const float* w_in = (const float*)d_in[2]; const float* qg = (const float*)d_in[3];
    const float* kg = (const float*)d_in[4]; const float* rpb = (const float*)d_in[5]; const float* og = (const float*)d_in[6]; const float* w_out = (const float*)d_in[7];
    const float* n2 = (const float*)d_in[8]; const float* w_gu = (const float*)d_in[9]; const float* cw = (const float*)d_in[10]; const float* cb = (const float*)d_in[11];
    const float* w_dn = (const float*)d_in[12];
    unsigned char* ws = (unsigned char*)d_ws; float* out = (float*)d_out;
    float2* rot1 = (float2*)(ws + WS_TAB); float2* rotax = rot1 + 4096 * 8;
    float* ssp = (float*)(ws + WS_SSP); float* lse = (float*)(ws + WS_LSE);
    bf16_t* XB = (bf16_t*)(ws + WS_XB); bf16_t* PROJ = (bf16_t*)(ws + WS_PROJ); bf16_t* OBUF = (bf16_t*)(ws + WS_OBUF); bf16_t* MIX = (bf16_t*)(ws + WS_MIX); bf16_t* ACT = (bf16_t*)(ws + WS_ACT);
    float* TMP = (float*)(ws + WS_TMP);
    auto phase = [&](int p) { a.ph_lo = p; a.ph_hi = p + 1; hipLaunchKernelGGL(fwd, dim3(grid), dim3(NWAVES * 64), LDS_TOTAL, stream, a); };
    const int F = DBG_FAST;
    if (F & 1) phase(0); else { k_tables<<<128, 256, 0, stream>>>(rot1, rotax); k_prep_x<<<M / 4, 256, 0, stream>>>(x, XB, ssp); }
    for (int l = 0; l < 2; ++l) {
        const float* src = l == 0 ? x : out; const int pb = 1 + 6 * l;
        if (F & 2) phase(pb); else for (int b = 0; b < BATCH; ++b) {
            k_ngemm<0><<<dim3(DIN / 64, SEQ / 64), 256, 0, stream>>>(XB + (size_t)b * SEQ * DM, DM, n1 + l * DM, w_in + (size_t)l * DM * DIN, DIN, DM, ssp + (size_t)b * SEQ * 16, TMP, DIN, nullptr);
            k_qkfix<<<SEQ * 40 / 256, 256, 0, stream>>>(TMP, b * SEQ, PROJ, qg + l * 192, kg + l * 192, rot1, rotax);
        }
        if (F & 4) phase(pb + 1); else {
            k_nattn<0><<<dim3(M / 256, 4), 256, 0, stream>>>(PROJ, OBUF, lse, rpb + l * 4 * 15 * 31, 0);
            for (int p = 0; p < 3; ++p) k_nattn<1><<<dim3(M / 256, 6), 256, 0, stream>>>(PROJ, OBUF, lse, nullptr, p);
            k_nattn<2><<<dim3(M / 256, 6), 256, 0, stream>>>(PROJ, OBUF, lse, nullptr, 0);
        }
        if (F & 8) phase(pb + 2); else k_mixfin<<<M / 4, 256, 0, stream>>>(OBUF, lse, og + l * DM, MIX);
        if (F & 16) phase(pb + 3); else {
            k_ngemm<1><<<dim3(DM / 64, M / 64), 256, 0, stream>>>(MIX, DM, nullptr, w_out + (size_t)l * DM * DM, DM, DM, nullptr, out, DM, src);
            k_prep_x<<<M / 4, 256, 0, stream>>>(out, XB, ssp);
        }
        if (F & 32) phase(pb + 4); else for (int b = 0; b < BATCH; ++b) {
            k_ngemm<0><<<dim3(2 * DFF / 64, SEQ / 64), 256, 0, stream>>>(XB + (size_t)b * SEQ * DM, DM, n2 + l * DM, w_gu + (size_t)l * DM * 2 * DFF, 2 * DFF, DM, ssp + (size_t)b * SEQ * 16, TMP, 2 * DFF, nullptr);
            k_conv<<<SEQ * DFF / 256, 256, 0, stream>>>(TMP, b * SEQ, cw + l * 3 * DFF, cb + l * DFF, ACT);
        }
        if (F & 64) phase(pb + 5); else {
            k_ngemm<1><<<dim3(DM / 64, M / 64), 256, 0, stream>>>(ACT, DFF, nullptr, w_dn + (size_t)l * DFF * DM, DM, DFF, nullptr, out, DM, out);
            if (l == 0) k_prep_x<<<M / 4, 256, 0, stream>>>(out, XB, ssp);
        }
    }
#endif
}
```

```cpp
#ifndef DBG_FAST
#define DBG_FAST -1
#endif
#include <hip/hip_runtime.h>
#include <hip/hip_cooperative_groups.h>
#include <hip/hip_bf16.h>
#include <cmath>
#include <cstdint>
#include <cstdio>

typedef unsigned short bf16_t;
constexpr int BATCH = 8, SEQ = 4096, DM = 1024, M = BATCH * SEQ, DIN = 2560, DFF = 2816;
constexpr int OB_LD = 1792;
constexpr float EPS = 1e-6f;
constexpr float LOG2E = 1.4426950408889634f;
constexpr float C2 = 0.125f * LOG2E;
constexpr size_t MiB = 1u << 20;
constexpr size_t WS_CTL = 0, WS_TAB = 1 * MiB, WS_SSP = 2 * MiB, WS_LSE = 4 * MiB, WS_W = 8 * MiB, WS_XB = 57 * MiB, WS_PROJ = 122 * MiB, WS_OBUF = 282 * MiB,
                 WS_MIX = 122 * MiB, WS_ACT = 122 * MiB, WS_TMP = 394 * MiB;

typedef float f32x2v_t __attribute__((ext_vector_type(2)));
__device__ const double INV1[8] = {1.0, 0.19392274474868576, 0.03760603093086393, 0.0072926647372171085, 0.0014142135623730952, 0.0002742481756762073, 5.318295896944988e-05, 1.0313385377212458e-05};
__device__ const double INV2[16] = {1.0, 0.5623413251903491, 0.31622776601683794, 0.1778279410038923, 0.09999999999999999, 0.056234132519034905, 0.03162277660168379, 0.01778279410038923,
                                    0.01, 0.005623413251903491, 0.0031622776601683794, 0.0017782794100389228, 0.001, 0.000562341325190349, 0.00031622776601683794, 0.0001778279410038923};

__device__ __forceinline__ float bf2f(bf16_t b) { return __uint_as_float(((unsigned)b) << 16); }
__device__ __forceinline__ bf16_t f2bf(float f) { unsigned u = __float_as_uint(f); return (bf16_t)((u + 0x7fffu + ((u >> 16) & 1u)) >> 16); }
__device__ __forceinline__ float wave_sum(float v) {
#pragma unroll
    for (int o = 1; o < 64; o <<= 1) v += __shfl_xor(v, o);
    return v;
}
__device__ __forceinline__ float2 sincos_d(double a) {
    const double k = rint(a * 0.63661977236758134308);
    double r = fma(-k, 1.57079632679489655800, a); r = fma(-k, 6.12323399573676603587e-17, r);
    const double r2 = r * r;
    const double sp = r * (1 + r2 * (-1 / 6. + r2 * (1 / 120. + r2 * (-1 / 5040. + r2 * (1 / 362880. + r2 * (-1 / 39916800. + r2 * (1 / 6227020800.)))))));
    const double cp = 1 + r2 * (-0.5 + r2 * (1 / 24. + r2 * (-1 / 720. + r2 * (1 / 40320. + r2 * (-1 / 3628800. + r2 * (1 / 479001600. + r2 * (-1 / 87178291200.)))))));
    const int q = (int)((long long)k & 3);
    double c, s;
    if (q == 0) { c = cp; s = sp; } else if (q == 1) { c = -sp; s = cp; } else if (q == 2) { c = -cp; s = -sp; } else { c = sp; s = -cp; }
    return make_float2((float)c, (float)s);
}
__device__ __forceinline__ float row_rstd(const float* ssp, int row) {
    const float4* p = (const float4*)(ssp + (size_t)row * 16);
    const float4 a = p[0], b = p[1], c = p[2], d = p[3];
    const float s = ((a.x + a.y) + (a.z + a.w)) + ((b.x + b.y) + (b.z + b.w)) + ((c.x + c.y) + (c.z + c.w)) + ((d.x + d.y) + (d.z + d.w));
    return rsqrtf(s * (1.0f / DM) + EPS);
}

#if 1
__global__ void k_tables(float2* rot1, float2* rotax) {
    const int i = blockIdx.x * 256 + threadIdx.x;
    if (i < 4096 * 8) rot1[i] = sincos_d((double)(i >> 3) * INV1[i & 7]);
    if (i < 64 * 16) rotax[i] = sincos_d((double)(i >> 4) * INV2[i & 15]);
}
__global__ __launch_bounds__(256) void k_prep_x(const float* __restrict__ x, bf16_t* xb, float* ssp) {
    const int row = blockIdx.x * 4 + (threadIdx.x >> 6), lane = threadIdx.x & 63;
    const float4* xr = (const float4*)(x + (size_t)row * DM);
    float ss = 0.f;
#pragma unroll
    for (int j = 0; j < 4; ++j) {
        const float4 v = xr[lane + 64 * j]; ss += (v.x * v.x + v.y * v.y) + (v.z * v.z + v.w * v.w);
        uint2 o; o.x = (unsigned)f2bf(v.x) | ((unsigned)f2bf(v.y) << 16); o.y = (unsigned)f2bf(v.z) | ((unsigned)f2bf(v.w) << 16);
        *(uint2*)(xb + (size_t)row * DM + (lane + 64 * j) * 4) = o;
    }
    ss = wave_sum(ss);
    if (lane < 16) ssp[(size_t)row * 16 + lane] = lane == 0 ? ss : 0.f;
}
template <int MODE> __global__ __launch_bounds__(256) void k_ngemm(const bf16_t* __restrict__ A, int lda, const float* __restrict__ gk, const float* __restrict__ W, int N, int K,
                                                                    const float* ssp, float* C, int ldc, const float* res) {
    __shared__ float As[16][68], Bs[16][64];
    const int tid = threadIdx.x, tx = tid & 15, ty = tid >> 4, m0 = blockIdx.y * 64, n0 = blockIdx.x * 64;
    float acc[4][4];
#pragma unroll
    for (int i = 0; i < 4; ++i)
#pragma unroll
        for (int j = 0; j < 4; ++j) acc[i][j] = 0.f;
    for (int k0 = 0; k0 < K; k0 += 16) {
        { const int r = tid >> 2, kk = (tid & 3) * 4; const bf16_t* ap = A + (size_t)(m0 + r) * lda + k0 + kk;
#pragma unroll
          for (int e = 0; e < 4; ++e) As[kk + e][r] = bf2f(ap[e]) * (gk ? gk[k0 + kk + e] : 1.f); }
        { const int kk = tid >> 4, nn = (tid & 15) * 4; const float4 w = *(const float4*)(W + (size_t)(k0 + kk) * N + n0 + nn); *(float4*)&Bs[kk][nn] = w; }
        __syncthreads();
#pragma unroll
        for (int kk = 0; kk < 16; ++kk) {
            float a[4], b[4];
#pragma unroll
            for (int i = 0; i < 4; ++i) a[i] = As[kk][ty * 4 + i];
#pragma unroll
            for (int j = 0; j < 4; ++j) b[j] = Bs[kk][tx * 4 + j];
#pragma unroll
            for (int i = 0; i < 4; ++i)
#pragma unroll
                for (int j = 0; j < 4; ++j) acc[i][j] += a[i] * b[j];
        }
        __syncthreads();
    }
#pragma unroll
    for (int i = 0; i < 4; ++i) {
        const int row = m0 + ty * 4 + i; const float rs = (MODE == 0 && ssp) ? row_rstd(ssp, row) : 1.f;
#pragma unroll
        for (int j = 0; j < 4; ++j) { const size_t o = (size_t)row * ldc + n0 + tx * 4 + j; C[o] = (MODE == 0) ? acc[i][j] * rs : res[o] + acc[i][j]; }
    }
}
__global__ __launch_bounds__(256) void k_qkfix(const float* __restrict__ tmp, int row0, bf16_t* proj, const float* qg, const float* kg, const float2* rot1, const float2* rotax) {
    const int idx = blockIdx.x * 256 + threadIdx.x, r = idx / 40, hd = idx % 40, row = row0 + r, t = row % SEQ;
    const float* src = tmp + (size_t)r * DIN + hd * 64; bf16_t* dst = proj + (size_t)row * DIN + hd * 64;
    int mixer, isq, isv = 0;
    if (hd < 4) { mixer = 0; isq = 1; } else if (hd < 8) { mixer = 0; isq = 0; } else if (hd < 12) { mixer = 0; isq = 0; isv = 1; }
    else if (hd < 18) { mixer = 1; isq = 1; } else if (hd < 24) { mixer = 1; isq = 0; } else if (hd < 30) { mixer = 1; isq = 0; isv = 1; }
    else if (hd < 36) { mixer = 2; isq = 1; } else if (hd < 38) { mixer = 2; isq = 0; } else { mixer = 2; isq = 0; isv = 1; }
    if (isv) { for (int i = 0; i < 64; ++i) dst[i] = f2bf(src[i]); return; }
    float ss = 0.f; for (int i = 0; i < 64; ++i) ss += src[i] * src[i];
    const float rs = rsqrtf(ss * (1.f / 64.f) + EPS) ; const float sc = isq ? C2 : 1.f;
    const float* g = (isq ? qg : kg) + mixer * 64;
    if (mixer == 0) { for (int i = 0; i < 64; ++i) dst[i] = f2bf(src[i] * rs * g[i] * sc); }
    else if (mixer == 1) {
        for (int i = 0; i < 8; ++i) { const float2 cs = rot1[t * 8 + i]; const float a = src[i] * rs * g[i], b = src[i + 8] * rs * g[i + 8];
            dst[i] = f2bf((a * cs.x - b * cs.y) * sc); dst[i + 8] = f2bf((b * cs.x + a * cs.y) * sc); }
        for (int i = 16; i < 64; ++i) dst[i] = f2bf(src[i] * rs * g[i] * sc);
    } else {
        for (int i = 0; i < 16; ++i) {
            { const float2 cs = rotax[(t >> 6) * 16 + i]; const float a = src[i] * rs * g[i], b = src[i + 16] * rs * g[i + 16];
              dst[i] = f2bf((a * cs.x - b * cs.y) * sc); dst[i + 16] = f2bf((b * cs.x + a * cs.y) * sc); }
            { const float2 cs = rotax[(t & 63) * 16 + i]; const float a = src[32 + i] * rs * g[32 + i], b = src[48 + i] * rs * g[48 + i];
              dst[32 + i] = f2bf((a * cs.x - b * cs.y) * sc); dst[48 + i] = f2bf((b * cs.x + a * cs.y) * sc); }
        }
    }
}
template <int MODE> __global__ __launch_bounds__(256) void k_nattn(const bf16_t* __restrict__ proj, bf16_t* obuf, float* lse, const float* __restrict__ rpb, int pat) {
    const int row = blockIdx.x * 256 + threadIdx.x, h = blockIdx.y, b = row / SEQ, t = row % SEQ;
    const int qcol = MODE == 0 ? h * 64 : MODE == 1 ? 768 + h * 64 : 1920 + h * 64;
    const int kcol = MODE == 0 ? 256 + h * 64 : MODE == 1 ? 1152 + h * 64 : 2304 + (h / 3) * 64;
    const int vcol = MODE == 0 ? 512 + h * 64 : MODE == 1 ? 1536 + h * 64 : 2432 + (h / 3) * 64;
    const int ocol = MODE == 0 ? h * 64 : MODE == 1 ? (pat == 0 ? 256 : pat == 1 ? 1024 : 1408) + h * 64 : 640 + h * 64;
    float q[64], o[64];
    { const uint4* qp = (const uint4*)(proj + (size_t)row * DIN + qcol);
#pragma unroll
      for (int c = 0; c < 8; ++c) { const uint4 v = qp[c]; const unsigned w[4] = {v.x, v.y, v.z, v.w};
#pragma unroll
          for (int e = 0; e < 4; ++e) { q[c * 8 + 2 * e] = __uint_as_float(w[e] << 16); q[c * 8 + 2 * e + 1] = __uint_as_float(w[e] & 0xffff0000u); } } }
#pragma unroll
    for (int d = 0; d < 64; ++d) o[d] = 0.f;
    float m = -1e30f, l = 0.f;
    const int nk = MODE == 0 ? 128 : MODE == 1 ? 129 : SEQ;
    const int dil = pat == 0 ? 1 : pat == 1 ? 4 : 16;
    const int gr = t >> 6, gc = t & 63;
    const int r0 = min(max(gr - 4, 0), 56), c0 = min(max(gc - 8, 0), 48);
    for (int j = 0; j < nk; ++j) {
        int tok; float bias = 0.f;
        if (MODE == 0) { const int kr = r0 + (j >> 4), kc = c0 + (j & 15); tok = kr * 64 + kc; bias = rpb[(h * 15 + (kr - gr + 7)) * 31 + (kc - gc + 15)] * LOG2E; }
        else if (MODE == 1) { tok = t + (j - 64) * dil; if (tok < 0 || tok >= SEQ) continue; }
        else tok = j;
        const uint4* kp = (const uint4*)(proj + (size_t)(b * SEQ + tok) * DIN + kcol);
        float s = bias;
#pragma unroll
        for (int c = 0; c < 8; ++c) { const uint4 v = kp[c]; const unsigned w[4] = {v.x, v.y, v.z, v.w};
#pragma unroll
            for (int e = 0; e < 4; ++e) { s += q[c * 8 + 2 * e] * __uint_as_float(w[e] << 16); s += q[c * 8 + 2 * e + 1] * __uint_as_float(w[e] & 0xffff0000u); } }
        const float mn = fmaxf(m, s), f = exp2f(m - mn), p = exp2f(s - mn);
        l = l * f + p; m = mn;
        const uint4* vp = (const uint4*)(proj + (size_t)(b * SEQ + tok) * DIN + vcol);
#pragma unroll
        for (int c = 0; c < 8; ++c) { const uint4 v = vp[c]; const unsigned w[4] = {v.x, v.y, v.z, v.w};
#pragma unroll
            for (int e = 0; e < 4; ++e) { o[c * 8 + 2 * e] = o[c * 8 + 2 * e] * f + p * __uint_as_float(w[e] << 16); o[c * 8 + 2 * e + 1] = o[c * 8 + 2 * e + 1] * f + p * __uint_as_float(w[e] & 0xffff0000u); } }
    }
    const float il = 1.f / l;
    bf16_t* op = obuf + (size_t)row * OB_LD + ocol;
#pragma unroll
    for (int d = 0; d < 64; d += 2) *(unsigned*)(op + d) = (unsigned)f2bf(o[d] * il) | ((unsigned)f2bf(o[d + 1] * il) << 16);
    if (MODE == 1) lse[((size_t)pat * M + row) * 6 + h] = m + log2f(l);
}
__global__ __launch_bounds__(256) void k_mixfin(const bf16_t* __restrict__ obuf, const float* __restrict__ lse, const float* __restrict__ og, bf16_t* mix) {
    const int row = blockIdx.x * 4 + (threadIdx.x >> 6), lane = threadIdx.x & 63;
    const bf16_t* ob = obuf + (size_t)row * OB_LD; bf16_t* mo = mix + (size_t)row * DM;
    { const uint2 v = *(const uint2*)(ob + lane * 4);
      const float a0 = __uint_as_float(v.x << 16), a1 = __uint_as_float(v.x & 0xffff0000u), a2 = __uint_as_float(v.y << 16), a3 = __uint_as_float(v.y & 0xffff0000u);
      const float ss = wave_sum((a0 * a0 + a1 * a1) + (a2 * a2 + a3 * a3)); const float rs = rsqrtf(ss * (1.f / 256.f) + EPS);
      const float4 g = *(const float4*)(og + lane * 4);
      uint2 o; o.x = (unsigned)f2bf(a0 * rs * g.x) | ((unsigned)f2bf(a1 * rs * g.y) << 16); o.y = (unsigned)f2bf(a2 * rs * g.z) | ((unsigned)f2bf(a3 * rs * g.w) << 16);
      *(uint2*)(mo + lane * 4) = o; }
    { float v[6]; float ss = 0.f;
#pragma unroll
      for (int j = 0; j < 6; ++j) {
          const float l0 = lse[((size_t)0 * M + row) * 6 + j], l1 = lse[((size_t)1 * M + row) * 6 + j], l2 = lse[((size_t)2 * M + row) * 6 + j];
          const float mx = fmaxf(l0, fmaxf(l1, l2)); const float w0 = exp2f(l0 - mx), w1 = exp2f(l1 - mx), w2 = exp2f(l2 - mx); const float iw = 1.f / (w0 + w1 + w2);
          v[j] = (w0 * bf2f(ob[256 + j * 64 + lane]) + w1 * bf2f(ob[1024 + j * 64 + lane]) + w2 * bf2f(ob[1408 + j * 64 + lane])) * iw; ss += v[j] * v[j]; }
      ss = wave_sum(ss); const float rs = rsqrtf(ss * (1.f / 384.f) + EPS);
#pragma unroll
      for (int j = 0; j < 6; ++j) mo[256 + j * 64 + lane] = f2bf(v[j] * rs * og[256 + j * 64 + lane]); }
    { float v[6]; float ss = 0.f;
#pragma unroll
      for (int j = 0; j < 6; ++j) { v[j] = bf2f(ob[640 + j * 64 + lane]); ss += v[j] * v[j]; }
      ss = wave_sum(ss); const float rs = rsqrtf(ss * (1.f / 384.f) + EPS);
#pragma unroll
      for (int j = 0; j < 6; ++j) mo[640 + j * 64 + lane] = f2bf(v[j] * rs * og[640 + j * 64 + lane]); }
}
__global__ __launch_bounds__(256) void k_conv(const float* __restrict__ tmp, int row0, const float* __restrict__ cw, const float* __restrict__ cb, bf16_t* act) {
    const int idx = blockIdx.x * 256 + threadIdx.x, r = idx / DFF, c = idx % DFF;
    const float g0 = r > 0 ? tmp[(size_t)(r - 1) * 2 * DFF + c] : 0.f, g1 = tmp[(size_t)r * 2 * DFF + c], g2 = r < SEQ - 1 ? tmp[(size_t)(r + 1) * 2 * DFF + c] : 0.f;
    const float u = tmp[(size_t)r * 2 * DFF + DFF + c];
    const float g = g0 * cw[c] + cb[c] + g1 * cw[DFF + c] + g2 * cw[2 * DFF + c];
    act[(size_t)(row0 + r) * DFF + c] = f2bf(0.5f * g * (1.f + erff(g * 0.70710678118654752f)) * u);
}

#endif

namespace pg8 {
#define PG8_LAS __attribute__((address_space(3)))
#ifndef WGM_SEL
#define WGM_SEL 2
#endif
typedef unsigned short bf16_t;
typedef short bf16x8 __attribute__((ext_vector_type(8)));
typedef float f32x4 __attribute__((ext_vector_type(4)));
typedef unsigned u32x4 __attribute__((ext_vector_type(4)));
constexpr int BM = 256, BK = 64, HALF = 128, HTB = HALF * BK * 2  , STAGE_BYTES = 8 * HTB, NXCD = 8, WGM = WGM_SEL;

__host__ __device__ __forceinline__ int lds_byte(int r, int c) { const int st = (r >> 4) * 2 + (c >> 5), rr = r & 15, cc = c & 31, ob = rr * 64 + cc * 2; return st * 1024 + (ob ^ (((ob >> 9) & 1) << 5)); }
__host__ __device__ __forceinline__ void stage_rc(int b, int& R, int& C) { const int st = b / 1024, sb = b % 1024, swz = sb ^ (((sb >> 9) & 1) << 5); R = (st >> 1) * 16 + swz / 64; C = (st & 1) * 32 + (swz % 64) / 2; }
__host__ __device__ __forceinline__ int perm32(int rho) { const int n = rho >> 4, i = rho & 15; return 8 * (i >> 2) + 4 * n + (i & 3); }

struct Unit { int pm, pn; };
struct Gemm { const bf16_t* A; const bf16_t* Bt; int M, N, K; int a_step, a_off; };

struct StaticOrder {
    int nM, nN, nwg, G, c; static constexpr int wgm = WGM, nmaj = 0;
    __host__ __device__ void init(int M, int N, int G_, int c_) { nM = M / BM; nN = N / BM; nwg = nM * nN; G = G_; c = c_; }
    __host__ __device__ void init2(int nM_, int nN_, int G_, int c_) { nM = nM_; nN = nN_; nwg = nM * nN; G = G_; c = c_; }
    __host__ __device__ bool next(int i, Unit& u) const {
        const long L = (long)i * G + c; if (L >= nwg) return false;
        int wgid = (int)L; { const int q = nwg / NXCD, r = nwg % NXCD, xcd = wgid % NXCD, off = wgid / NXCD; wgid = (xcd < r ? xcd * (q + 1) : r * (q + 1) + (xcd - r) * q) + off; }
        const int nig = wgm * nN, gid = wgid / nig, fm = gid * wgm, gsz = (nM - fm) < wgm ? (nM - fm) : wgm;
        if (nmaj) { const int nig2 = wgm * nM, gid2 = wgid / nig2, fn = gid2 * wgm, gs2 = (nN - fn) < wgm ? (nN - fn) : wgm; u.pn = fn + ((wgid % nig2) % gs2); u.pm = (wgid % nig2) / gs2; return true; }
        u.pm = fm + ((wgid % nig) % gsz); u.pn = (wgid % nig) / gsz; return true;
    }
    __device__ __forceinline__ void a_ready(const Unit&) const {}
    __device__ __forceinline__ void done(const Unit&) const {}
};

__device__ __forceinline__ unsigned cvt_pk_bf16(float lo, float hi) { unsigned r; asm volatile("v_cvt_pk_bf16_f32 %0, %1, %2" : "=v"(r) : "v"(lo), "v"(hi)); return r; }
typedef float f32x2 __attribute__((ext_vector_type(2)));
__device__ __forceinline__ f32x2 gelu_pk(f32x2 v) {
    f32x2 nav; nav.x = __uint_as_float(__float_as_uint(v.x) | 0x80000000u); nav.y = __uint_as_float(__float_as_uint(v.y) | 0x80000000u);
    const f32x2 d = nav * (-0.2316418882f) + 1.0f;
    f32x2 t; t.x = __builtin_amdgcn_rcpf(d.x); t.y = __builtin_amdgcn_rcpf(d.y);
    f32x2 q = t * 0.5307027145f + (-0.7265760135f); q = q * t + 0.7107068705f; q = q * t + (-0.142248368f); q = q * t + 0.127414796f; q = q * t;
    const f32x2 s = (v * v) * (-0.72134752044f);
    f32x2 e; e.x = __builtin_amdgcn_exp2f(s.x); e.y = __builtin_amdgcn_exp2f(s.y);
    f32x2 rl; rl.x = __builtin_fmaxf(v.x, 0.f); rl.y = __builtin_fmaxf(v.y, 0.f);
    return nav * (q * e) + rl;
}
__device__ __forceinline__ float row_rstd_g(const float* ssp, int row) {
    const f32x4* p = (const f32x4*)(ssp + (size_t)row * 16);
    const f32x4 a = p[0], b = p[1], c = p[2], d = p[3];
    const float s = ((a[0] + a[1]) + (a[2] + a[3])) + ((b[0] + b[1]) + (b[2] + b[3])) + ((c[0] + c[1]) + (c[2] + c[3])) + ((d[0] + d[1]) + (d[2] + d[3]));
    return __builtin_amdgcn_rsqf(s * (1.0f / 1024.0f) + 1e-6f);
}
typedef float f32x2v __attribute__((ext_vector_type(2)));
#ifndef NT_EPI
#define NT_EPI 0
#endif
#if NT_EPI
#define NT_STORE16(p, v) __builtin_nontemporal_store((v), (p))
#else
#define NT_STORE16(p, v) (*(p) = (v))
#endif
__device__ __forceinline__ f32x2 gelu_poly_pk(f32x2 v) {
    const f32x2 z = v * 0.70710678118654752f; f32x2 zc; zc.x = __builtin_amdgcn_fmed3f(z.x, -3.6f, 3.6f); zc.y = __builtin_amdgcn_fmed3f(z.y, -3.6f, 3.6f);
    const f32x2 u = (zc * zc) * (2.0f / 12.96f) - 1.0f;
    f32x2 p = u * 2.149422857e-03f + (-5.741538245e-03f);
    p = p * u + 5.897893566e-03f; p = p * u + (-8.305349284e-03f); p = p * u + 1.989052295e-02f; p = p * u + (-3.436241872e-02f); p = p * u + 4.892587253e-02f;
    p = p * u + (-6.755373953e-02f); p = p * u + 8.967999166e-02f; p = p * u + (-1.138468536e-01f); p = p * u + 1.438208186e-01f; p = p * u + (-1.954888562e-01f); p = p * u + 3.927120064e-01f;
    const f32x2 h = v * 0.5f; return h * (zc * p) + h;
}
__device__ __forceinline__ float quad_row_sum(float s) {
    { const auto a = __builtin_amdgcn_permlane16_swap(__float_as_uint(s), __float_as_uint(s), false, false); s = __uint_as_float(a[0]) + __uint_as_float(a[1]); }
    { const auto b = __builtin_amdgcn_permlane32_swap(__float_as_uint(s), __float_as_uint(s), false, false); s = __uint_as_float(b[0]) + __uint_as_float(b[1]); }
    return s;
}
__device__ __forceinline__ float row_rstd_q(const float* ssp, int row, int fq) {
    const f32x4 a = *((const f32x4*)(ssp + (size_t)row * 16) + fq);
    float s = (a[0] + a[1]) + (a[2] + a[3]); s = quad_row_sum(s);
    return __builtin_amdgcn_rsqf(s * (1.0f / 1024.0f) + 1e-6f);
}
struct EpiIn {
    static constexpr bool PERM = true, AFTER_DRAIN = false;
    bf16_t* proj; const float* ssp; const float* qg; const float* kg; const f32x2v* rot1; const f32x2v* rotax;
    __device__ __forceinline__ void operator()(const f32x4 (&acc)[2][2][4][2], const Unit& u, int wr, int wc, int fr, int fq) const {
        asm volatile("" : "+v"(fr), "+v"(fq));
        const int hd = u.pn * 4 + wc;
        int mixer, isq, isv = 0;
        if (hd < 4) { mixer = 0; isq = 1; } else if (hd < 8) { mixer = 0; isq = 0; } else if (hd < 12) { mixer = 0; isq = 0; isv = 1; }
        else if (hd < 18) { mixer = 1; isq = 1; } else if (hd < 24) { mixer = 1; isq = 0; } else if (hd < 30) { mixer = 1; isq = 0; isv = 1; }
        else if (hd < 36) { mixer = 2; isq = 1; } else if (hd < 38) { mixer = 2; isq = 0; } else { mixer = 2; isq = 0; isv = 1; }
        int cb[2];
        if (isv || mixer == 0) { cb[0] = 8 * fq; cb[1] = 32 + 8 * fq; }
        else if (mixer == 1) { if (fq == 0) { cb[0] = 0; cb[1] = 8; } else { cb[0] = 8 * fq + 8; cb[1] = 8 * fq + 32; } }
        else { if (fq < 2) { cb[0] = 8 * fq; cb[1] = 16 + 8 * fq; } else { cb[0] = 8 * fq + 16; cb[1] = 8 * fq + 32; } }
        f32x4 gv[2][2];
        const float* g = (isq ? qg : kg) + mixer * 64; const float sc = isq ? 0.125f * 1.4426950408889634f : 1.f;
#pragma unroll
        for (int bj = 0; bj < 2; ++bj)
#pragma unroll
            for (int n = 0; n < 2; ++n) gv[bj][n] = isv ? (f32x4){1.f, 1.f, 1.f, 1.f} : *(const f32x4*)(g + cb[bj] + 4 * n) * sc;
        const int rowb = u.pm * BM + wr * 64 + fr;
        float rsv[8];
        { f32x4 sa[4], sb[4];
#pragma unroll
          for (int i = 0; i < 4; ++i) sa[i] = *((const f32x4*)(ssp + (size_t)(rowb + i * 16) * 16) + fq);
#pragma unroll
          for (int i = 0; i < 4; ++i) sb[i] = *((const f32x4*)(ssp + (size_t)(rowb + HALF + i * 16) * 16) + fq);
#pragma unroll
          for (int i = 0; i < 4; ++i) rsv[i] = __builtin_amdgcn_rsqf(quad_row_sum((sa[i][0] + sa[i][1]) + (sa[i][2] + sa[i][3])) * (1.0f / 1024.0f) + 1e-6f);
#pragma unroll
          for (int i = 0; i < 4; ++i) rsv[4 + i] = __builtin_amdgcn_rsqf(quad_row_sum((sb[i][0] + sb[i][1]) + (sb[i][2] + sb[i][3])) * (1.0f / 1024.0f) + 1e-6f);
          asm volatile("" : "+v"(rsv[0]), "+v"(rsv[1]), "+v"(rsv[2]), "+v"(rsv[3]), "+v"(rsv[4]), "+v"(rsv[5]), "+v"(rsv[6]), "+v"(rsv[7])); }
        const bool rot = !isv && mixer != 0 && (mixer == 2 || fq == 0);
        auto tabp = [&](int row) -> const f32x4* { const int t = row & 4095; return (const f32x4*)(mixer == 1 ? (rot1 + t * 8) : (rotax + ((fq < 2) ? (t >> 6) : (t & 63)) * 16 + (fq & 1) * 8)); };
        f32x4 tb[2][4];
        if (rot) { const f32x4* p = tabp(rowb);
#pragma unroll
            for (int k = 0; k < 4; ++k) tb[0][k] = p[k]; }
#pragma unroll
        for (int i = 0; i < 8; ++i) {
            const int ai = i >> 2, m = i & 3; const int row = rowb + ai * HALF + m * 16;
            if (rot && i < 7) { const f32x4* p = tabp(rowb + ((i + 1) >> 2) * HALF + ((i + 1) & 3) * 16);
#pragma unroll
                for (int k = 0; k < 4; ++k) tb[(i + 1) & 1][k] = p[k]; }
            const float rs = rsv[i];
            f32x4 v[2][2];
#pragma unroll
            for (int bj = 0; bj < 2; ++bj)
#pragma unroll
                for (int n = 0; n < 2; ++n) v[bj][n] = acc[ai][bj][m][n] * rs;
            if (!isv) {
                float ss = 0.f; f32x2 s2 = {0.f, 0.f};
#pragma unroll
                for (int bj = 0; bj < 2; ++bj)
#pragma unroll
                    for (int n = 0; n < 2; ++n) { const f32x4 x = v[bj][n]; const f32x2 xa = {x[0], x[1]}, xb = {x[2], x[3]}; s2 = xa * xa + s2; s2 = xb * xb + s2; }
                ss = quad_row_sum(s2.x + s2.y);
                const float r2 = __builtin_amdgcn_rsqf(ss * (1.0f / 64.0f) + 1e-6f);
#pragma unroll
                for (int bj = 0; bj < 2; ++bj)
#pragma unroll
                    for (int n = 0; n < 2; ++n) v[bj][n] = v[bj][n] * r2 * gv[bj][n];
                if (rot) {
#pragma unroll
                    for (int n = 0; n < 2; ++n)
#pragma unroll
                        for (int e = 0; e < 4; ++e) { const f32x4 q = tb[i & 1][2 * n + (e >> 1)]; const float c = q[2 * (e & 1)], sn = q[2 * (e & 1) + 1]; const float a = v[0][n][e], b = v[1][n][e]; v[0][n][e] = __builtin_fmaf(a, c, -(b * sn)); v[1][n][e] = __builtin_fmaf(b, c, a * sn); }
                }
            }
            bf16_t* rowp = proj + (size_t)row * 2560 + hd * 64;
#pragma unroll
            for (int bj = 0; bj < 2; ++bj) { u32x4 w; w.x = cvt_pk_bf16(v[bj][0][0], v[bj][0][1]); w.y = cvt_pk_bf16(v[bj][0][2], v[bj][0][3]); w.z = cvt_pk_bf16(v[bj][1][0], v[bj][1][1]); w.w = cvt_pk_bf16(v[bj][1][2], v[bj][1][3]);
                NT_STORE16((u32x4*)(rowp + cb[bj]), w); }
            asm volatile("" ::: "memory");
        }
    }
};
struct EpiRes {
    static constexpr bool PERM = false, AFTER_DRAIN = false;
    const float* res; float* out; bf16_t* xb; float* sspo;
    __device__ __forceinline__ void operator()(const f32x4 (&acc)[2][2][4][2], const Unit& u, int wr, int wc, int fr, int fq) const {
        asm volatile("" : "+v"(fr), "+v"(fq));
        const int col0 = u.pn * BM + wc * 32 + 4 * fq;
        const size_t off0 = (size_t)(u.pm * BM + wr * 64 + fr) * 1024 + col0;
        f32x4 rb[2][2][2];
#pragma unroll
        for (int bj = 0; bj < 2; ++bj)
#pragma unroll
            for (int n = 0; n < 2; ++n) rb[0][bj][n] = *(const f32x4*)(res + off0 + bj * HALF + n * 16);
#pragma unroll
        for (int i = 0; i < 8; ++i) {
            const int ai = i >> 2, m = i & 3; const int row = u.pm * BM + ai * HALF + wr * 64 + m * 16 + fr; const size_t off = (size_t)row * 1024 + col0; f32x2 s2 = {0.f, 0.f};
            if (i < 7) { const size_t offn = off0 + (size_t)(((i + 1) >> 2) * HALF + ((i + 1) & 3) * 16) * 1024;
#pragma unroll
                for (int bj = 0; bj < 2; ++bj)
#pragma unroll
                    for (int n = 0; n < 2; ++n) rb[(i + 1) & 1][bj][n] = *(const f32x4*)(res + offn + bj * HALF + n * 16); }
#pragma unroll
            for (int bj = 0; bj < 2; ++bj)
#pragma unroll
                for (int n = 0; n < 2; ++n) { const size_t o2 = off + bj * HALF + n * 16; const f32x4 o = rb[i & 1][bj][n] + acc[ai][bj][m][n]; *(f32x4*)(out + o2) = o;
                    { const f32x2 oa = {o[0], o[1]}, ob = {o[2], o[3]}; s2 = oa * oa + s2; s2 = ob * ob + s2; }
                    if (xb) { f32x2v w; w.x = __uint_as_float(cvt_pk_bf16(o[0], o[1])); w.y = __uint_as_float(cvt_pk_bf16(o[2], o[3])); *(f32x2v*)(xb + o2) = w; } }
            if (sspo) { const float ss = quad_row_sum(s2.x + s2.y); if (fq == 0) sspo[(size_t)row * 16 + u.pn * 4 + wc] = ss; }
            asm volatile("" ::: "memory");
        }
    }
};
template <int CTRL> __device__ __forceinline__ float dpp_mov(float v) { return __uint_as_float((unsigned)__builtin_amdgcn_mov_dpp((int)__float_as_uint(v), CTRL, 0xf, 0xf, true)); }
struct EpiGateConv {
    static constexpr bool PERM = true, AFTER_DRAIN = false;
    bf16_t* act; const float* ssp; const float* cw; const float* cb; PG8_LAS float* halo; int cheap;
    __device__ __forceinline__ void operator()(f32x4 (&acc)[2][2][4][2], const Unit& u, int wr, int wc, int fr, int fq) const {
        asm volatile("" : "+v"(fr), "+v"(fq));
        const int grow0 = 254 * u.pm - 1, lr0 = wr * 64 + fr;
        {
            f32x4 sv[2][4];
#pragma unroll
            for (int ai = 0; ai < 2; ++ai)
#pragma unroll
                for (int m = 0; m < 4; ++m) { int gr = grow0 + lr0 + ai * HALF + m * 16; gr = gr < 0 ? 0 : (gr > 32767 ? 32767 : gr); sv[ai][m] = *((const f32x4*)(ssp + (size_t)gr * 16) + fq); }
#pragma unroll
            for (int ai = 0; ai < 2; ++ai)
#pragma unroll
                for (int m = 0; m < 4; ++m) { const f32x4 a = sv[ai][m]; const float s_ = quad_row_sum((a[0] + a[1]) + (a[2] + a[3])); const float rs = __builtin_amdgcn_rsqf(s_ * (1.0f / 1024.0f) + 1e-6f);
#pragma unroll
                    for (int bj = 0; bj < 2; ++bj)
#pragma unroll
                        for (int n = 0; n < 2; ++n) acc[ai][bj][m][n] *= rs;
                    asm volatile("" : "+v"(acc[ai][0][m][0]), "+v"(acc[ai][0][m][1]), "+v"(acc[ai][1][m][0]), "+v"(acc[ai][1][m][1])); }
        }
        const int hc = wc * 32 + 8 * fq;
        const int ch0 = 128 * u.pn + hc;
        f32x4 wq[4]; wq[0] = *(const f32x4*)(cw + ch0); wq[1] = *(const f32x4*)(cw + 2816 + ch0); wq[2] = *(const f32x4*)(cw + 5632 + ch0); wq[3] = *(const f32x4*)(cb + ch0);
#pragma unroll
        for (int ai = 0; ai < 2; ++ai) { const int blk = 2 * ai + wr;
            if (fr == 0) { *(PG8_LAS f32x4*)(halo + (blk * 2 + 0) * 128 + hc) = acc[ai][0][0][0]; *(PG8_LAS f32x4*)(halo + (blk * 2 + 0) * 128 + hc + 4) = acc[ai][0][0][1]; }
            if (fr == 15) { *(PG8_LAS f32x4*)(halo + (blk * 2 + 1) * 128 + hc) = acc[ai][0][3][0]; *(PG8_LAS f32x4*)(halo + (blk * 2 + 1) * 128 + hc + 4) = acc[ai][0][3][1]; } }
        asm volatile("s_waitcnt lgkmcnt(0)" ::: "memory"); __builtin_amdgcn_s_barrier(); asm volatile("" ::: "memory");
        if (!cheap)
#pragma unroll
        for (int n = 0; n < 2; ++n) {
            const f32x4 w0 = wq[0], w1 = wq[1], w2 = wq[2], bb = wq[3];
            if (n == 0) { wq[0] = *(const f32x4*)(cw + ch0 + 4); wq[1] = *(const f32x4*)(cw + 2816 + ch0 + 4); wq[2] = *(const f32x4*)(cw + 5632 + ch0 + 4); wq[3] = *(const f32x4*)(cb + ch0 + 4); }
#pragma unroll
            for (int ai = 0; ai < 2; ++ai) {
                const int blk = 2 * ai + wr;
                const f32x4 hp = blk > 0 ? *(PG8_LAS f32x4*)(halo + ((blk - 1) * 2 + 1) * 128 + hc + 4 * n) : (f32x4){0.f, 0.f, 0.f, 0.f};
                const f32x4 hn = blk < 3 ? *(PG8_LAS f32x4*)(halo + ((blk + 1) * 2 + 0) * 128 + hc + 4 * n) : (f32x4){0.f, 0.f, 0.f, 0.f};
#pragma unroll
                for (int e2 = 0; e2 < 4; e2 += 2) {
                    float gcv[4][2];
#pragma unroll
                    for (int ee = 0; ee < 2; ++ee) { const int e = e2 + ee;
                        float rr[4], ll[4];
                        float gsrc[4] = {acc[ai][0][0][n][e], acc[ai][0][1][n][e], acc[ai][0][2][n][e], acc[ai][0][3][n][e]};
                        asm volatile("" : "+v"(gsrc[0]), "+v"(gsrc[1]), "+v"(gsrc[2]), "+v"(gsrc[3]));
#pragma unroll
                        for (int m = 0; m < 4; ++m) { rr[m] = dpp_mov<0x121>(gsrc[m]); ll[m] = dpp_mov<0x12F>(gsrc[m]); }
#pragma unroll
                        for (int m = 0; m < 4; ++m) {
                            const int lr = lr0 + ai * HALF + m * 16, tt = (grow0 + lr) & 4095;
                            float up = fr > 0 ? rr[m] : (m > 0 ? rr[m > 0 ? m - 1 : 0] : hp[e]);
                            float dn = fr < 15 ? ll[m] : (m < 3 ? ll[m < 3 ? m + 1 : 3] : hn[e]);
                            if (tt == 0) up = 0.f;
                            if (tt == 4095) dn = 0.f;
                            float gc = __builtin_fmaf(up, w0[e], bb[e]); gc = __builtin_fmaf(gsrc[m], w1[e], gc); gc = __builtin_fmaf(dn, w2[e], gc);
                            gcv[m][ee] = gc;
                        }
                    }
#pragma unroll
                    for (int m = 0; m < 4; ++m) { const f32x2 a = gelu_pk((f32x2){gcv[m][0], gcv[m][1]}); acc[ai][0][m][n][e2] = a.x * acc[ai][1][m][n][e2]; acc[ai][0][m][n][e2 + 1] = a.y * acc[ai][1][m][n][e2 + 1]; }
                    asm volatile("" : "+v"(acc[ai][0][0][n]), "+v"(acc[ai][0][1][n]), "+v"(acc[ai][0][2][n]), "+v"(acc[ai][0][3][n]));
                }
            }
            asm volatile("" ::: "memory");
        }
#pragma unroll
        for (int ai = 0; ai < 2; ++ai)
#pragma unroll
            for (int m = 0; m < 4; ++m) {
                const int lr = lr0 + ai * HALF + m * 16, gr = grow0 + lr;
                if (lr >= 1 && lr <= 254 && gr < 32768) { const f32x4 o0 = acc[ai][0][m][0], o1 = acc[ai][0][m][1];
                    u32x4 w; w.x = cvt_pk_bf16(o0[0], o0[1]); w.y = cvt_pk_bf16(o0[2], o0[3]); w.z = cvt_pk_bf16(o1[0], o1[1]); w.w = cvt_pk_bf16(o1[2], o1[3]);
                    NT_STORE16((u32x4*)(act + (size_t)gr * 2816 + ch0), w); }
            }
    }
};
template <class Epi, class Sched, bool ALIGN_EPI = false, bool SP2 = false>
__device__ __forceinline__ void gemm_phase(PG8_LAS unsigned char* lds, const Gemm g, const Sched& S, const Epi& E, int tid_in) {
    const int tid = tid_in, wid = __builtin_amdgcn_readfirstlane(tid >> 6), lane = tid & 63, wr = wid >> 2, wc = wid & 3, fr = lane & 15, fq = lane >> 4;
    const int K = g.K, nt = K / BK;
    unsigned voffA[2], voffB[2];
#pragma unroll
    for (int i = 0; i < 2; ++i) { int R, C; stage_rc(tid * 16 + i * 8192, R, C); const int Rb = Epi::PERM ? ((R & ~31) + perm32(R & 31)) : R;
        voffA[i] = (unsigned)(R * K + C) * 2u; voffB[i] = (unsigned)(Rb * K + C) * 2u; }
    const size_t kstep = (size_t)(BK * 2);
    const size_t hstep = (size_t)HALF * K * 2;
    const size_t tstep = 2 * hstep;
    const unsigned ldsw = (unsigned)wid * 1024u;
    const int aoff = lds_byte(wr * 64 + fr, fq * 8), boff = lds_byte(wc * 32 + fr, fq * 8);
#define PG8_SA(b, h) (((b) * 2 + (h)) * HTB)
#define PG8_SB(b, h) ((4 + (b) * 2 + (h)) * HTB)
#define PG8_STAGE(bufoff, gbase, voff) do { _Pragma("unroll") for (int _i = 0; _i < 2; ++_i) \
        __builtin_amdgcn_global_load_lds((const unsigned*)((const char*)(gbase) + (voff)[_i]), (PG8_LAS unsigned*)(lds + (bufoff) + ldsw + _i * 8192), 16, 0, 0); } while (0)
#ifndef B_AUX
#define B_AUX 0
#endif
#define PG8_STAGEB(bufoff, gbase, voff) do { _Pragma("unroll") for (int _i = 0; _i < 2; ++_i) \
        __builtin_amdgcn_global_load_lds((const unsigned*)((const char*)(gbase) + (voff)[_i]), (PG8_LAS unsigned*)(lds + (bufoff) + ldsw + _i * 8192), 16, 0, B_AUX); } while (0)
#define PG8_LDA(dst, b, h) do { _Pragma("unroll") for (int m = 0; m < 4; ++m) _Pragma("unroll") for (int k = 0; k < 2; ++k) dst[m][k] = *(const PG8_LAS bf16x8*)(lds + PG8_SA(b, h) + aoff + m * 2048 + k * 1024); } while (0)
#define PG8_LDB(dst, b, h) do { _Pragma("unroll") for (int n = 0; n < 2; ++n) _Pragma("unroll") for (int k = 0; k < 2; ++k) dst[n][k] = *(const PG8_LAS bf16x8*)(lds + PG8_SB(b, h) + boff + n * 2048 + k * 1024); } while (0)
#define PG8_MMA(ai, bj, At, Bt) do { __builtin_amdgcn_s_setprio(1); _Pragma("unroll") for (int m = 0; m < 4; ++m) _Pragma("unroll") for (int n = 0; n < 2; ++n) _Pragma("unroll") for (int k = 0; k < 2; ++k) \
        acc[ai][bj][m][n] = __builtin_amdgcn_mfma_f32_16x16x32_bf16(Bt[n][k], At[m][k], acc[ai][bj][m][n], 0, 0, 0); __builtin_amdgcn_s_setprio(0); } while (0)
#define PG8_WAIT_V(n) asm volatile("s_waitcnt vmcnt(" #n ")" ::: "memory")
#define PG8_WAIT_L(n) asm volatile("s_waitcnt lgkmcnt(" #n ")" ::: "memory")
#define PG8_BAR __builtin_amdgcn_s_barrier()
#define PG8_SCHED __builtin_amdgcn_sched_barrier(0)
    Unit cur, nxt; int ui = 0;
    if (!S.next(0, cur)) return;
    f32x4 acc[2][2][4][2];
#pragma unroll
    for (int a = 0; a < 2; ++a)
#pragma unroll
        for (int b = 0; b < 2; ++b)
#pragma unroll
            for (int m = 0; m < 4; ++m)
#pragma unroll
                for (int n = 0; n < 2; ++n) acc[a][b][m][n] = (f32x4){0.f, 0.f, 0.f, 0.f};
    bf16x8 At[4][2], B0[2][2], B1[2][2];
    const char* cA = (const char*)g.A + ((long)cur.pm * g.a_step + g.a_off) * (long)(K * 2); const char* cB = (const char*)g.Bt + (size_t)cur.pn * tstep;
    S.a_ready(cur);
    if constexpr (SP2) {
        PG8_STAGEB(PG8_SB(0, 0), cB, voffB); PG8_STAGEB(PG8_SB(0, 1), cB + hstep, voffB); PG8_STAGE(PG8_SA(0, 0), cA, voffA); PG8_STAGE(PG8_SA(0, 1), cA + hstep, voffA);
        if (wr == 1) PG8_BAR;
        PG8_WAIT_V(2); PG8_BAR;
        PG8_STAGEB(PG8_SB(1, 0), cB + kstep, voffB); PG8_STAGE(PG8_SA(1, 0), cA + kstep, voffA); PG8_STAGEB(PG8_SB(1, 1), cB + hstep + kstep, voffB);
        PG8_WAIT_V(6); PG8_BAR;
    } else {
        PG8_STAGEB(PG8_SB(0, 0), cB, voffB); PG8_STAGE(PG8_SA(0, 0), cA, voffA); PG8_STAGEB(PG8_SB(0, 1), cB + hstep, voffB); PG8_STAGE(PG8_SA(0, 1), cA + hstep, voffA);
        if (wr == 1) PG8_BAR;
        PG8_WAIT_V(4); PG8_BAR;
        PG8_STAGEB(PG8_SB(1, 0), cB + kstep, voffB); PG8_STAGE(PG8_SA(1, 0), cA + kstep, voffA); PG8_STAGEB(PG8_SB(1, 1), cB + hstep + kstep, voffB);
        PG8_WAIT_V(6); PG8_BAR;
    }
    for (;;) {
        const bool has_next = S.next(ui + 1, nxt);
        const char* nA = has_next ? (const char*)g.A + ((long)nxt.pm * g.a_step + g.a_off) * (long)(K * 2) : cA; const char* nB = has_next ? (const char*)g.Bt + (size_t)nxt.pn * tstep : cB;
        for (int t = 0; t < nt; t += 2) {
            const bool last = (t == nt - 2);
            const char* a1 = cA + (size_t)(t + 1) * kstep;
            const char* a2 = last ? nA : cA + (size_t)(t + 2) * kstep; const char* b2 = last ? nB : cB + (size_t)(t + 2) * kstep;
            const char* a3 = a2 + kstep; const char* b3 = b2 + kstep;
            if (last && has_next) S.a_ready(nxt);
            if constexpr (SP2) {
            PG8_LDB(B0, 0, 0); PG8_LDB(B1, 0, 1); PG8_SCHED; PG8_LDA(At, 0, 0); PG8_STAGE(PG8_SA(1, 1), a1 + hstep, voffA);
            PG8_WAIT_V(8); PG8_WAIT_L(0); PG8_BAR; PG8_MMA(0, 0, At, B0); PG8_MMA(0, 1, At, B1); PG8_BAR; PG8_SCHED;
            PG8_LDA(At, 0, 1); PG8_STAGEB(PG8_SB(0, 0), b2, voffB); PG8_STAGEB(PG8_SB(0, 1), b2 + hstep, voffB); PG8_STAGE(PG8_SA(0, 0), a2, voffA);
            PG8_WAIT_V(8); PG8_WAIT_L(0); PG8_BAR; PG8_MMA(1, 0, At, B0); PG8_MMA(1, 1, At, B1); PG8_BAR; PG8_SCHED;
            PG8_LDB(B0, 1, 0); PG8_LDB(B1, 1, 1); PG8_SCHED; PG8_LDA(At, 1, 0); PG8_STAGE(PG8_SA(0, 1), a2 + hstep, voffA);
            PG8_WAIT_V(8); PG8_WAIT_L(0); PG8_BAR; PG8_MMA(0, 0, At, B0); PG8_MMA(0, 1, At, B1); PG8_BAR; PG8_SCHED;
            PG8_LDA(At, 1, 1); PG8_STAGEB(PG8_SB(1, 0), b3, voffB); PG8_STAGEB(PG8_SB(1, 1), b3 + hstep, voffB); PG8_STAGE(PG8_SA(1, 0), a3, voffA);
            PG8_WAIT_V(8); PG8_WAIT_L(0); PG8_BAR; PG8_MMA(1, 0, At, B0); PG8_MMA(1, 1, At, B1); PG8_BAR; PG8_SCHED;
            } else {
            PG8_LDB(B0, 0, 0); PG8_SCHED; PG8_LDA(At, 0, 0); PG8_STAGE(PG8_SA(1, 1), a1 + hstep, voffA);
            PG8_WAIT_L(8); PG8_BAR; PG8_WAIT_L(0); PG8_MMA(0, 0, At, B0); PG8_BAR; PG8_SCHED;
            PG8_LDB(B1, 0, 1); PG8_STAGEB(PG8_SB(0, 0), b2, voffB);
            PG8_BAR; PG8_WAIT_L(0); PG8_MMA(0, 1, At, B1); PG8_BAR;
            PG8_LDA(At, 0, 1); PG8_STAGE(PG8_SA(0, 0), a2, voffA);
            PG8_BAR; PG8_WAIT_L(0); PG8_MMA(1, 0, At, B0); PG8_BAR; PG8_SCHED;
            PG8_STAGEB(PG8_SB(0, 1), b2 + hstep, voffB);
            PG8_WAIT_V(6); PG8_BAR; PG8_MMA(1, 1, At, B1); PG8_BAR;
            PG8_LDB(B0, 1, 0); PG8_SCHED; PG8_LDA(At, 1, 0); PG8_STAGE(PG8_SA(0, 1), a2 + hstep, voffA);
            PG8_WAIT_L(8); PG8_BAR; PG8_WAIT_L(0); PG8_MMA(0, 0, At, B0); PG8_BAR; PG8_SCHED;
            PG8_LDB(B1, 1, 1); PG8_STAGEB(PG8_SB(1, 0), b3, voffB);
            PG8_BAR; PG8_WAIT_L(0); PG8_MMA(0, 1, At, B1); PG8_BAR;
            PG8_LDA(At, 1, 1); PG8_STAGE(PG8_SA(1, 0), a3, voffA);
            PG8_BAR; PG8_WAIT_L(0); PG8_MMA(1, 0, At, B0); PG8_BAR; PG8_SCHED;
            PG8_STAGEB(PG8_SB(1, 1), b3 + hstep, voffB);
            PG8_WAIT_V(6); PG8_BAR; PG8_MMA(1, 1, At, B1); PG8_BAR;
            }
        }
        if constexpr (ALIGN_EPI) { if (wr == 0) PG8_BAR; }
        if constexpr (!Epi::AFTER_DRAIN) { E(acc, cur, wr, wc, fr, fq); S.done(cur); }
        if (!has_next) break;
#pragma unroll
        for (int a = 0; a < 2; ++a)
#pragma unroll
            for (int b = 0; b < 2; ++b)
#pragma unroll
                for (int m = 0; m < 4; ++m)
#pragma unroll
                    for (int n = 0; n < 2; ++n) acc[a][b][m][n] = (f32x4){0.f, 0.f, 0.f, 0.f};
        cur = nxt; cA = nA; cB = nB; ++ui;
        if constexpr (ALIGN_EPI) { if (wr == 1) PG8_BAR; }
    }
    PG8_WAIT_V(0);
    if constexpr (!ALIGN_EPI) { if (wr == 0) PG8_BAR; }
    PG8_BAR;
    if constexpr (Epi::AFTER_DRAIN) { E.fused(acc, cur, wr, wc, fr, fq, lds, wid, lane); S.done(cur); }
#undef PG8_SA
#undef PG8_SB
#undef PG8_STAGE
#undef PG8_STAGEB
#undef PG8_LDA
#undef PG8_LDB
#undef PG8_MMA
#undef PG8_WAIT_V
#undef PG8_WAIT_L
#undef PG8_BAR
#undef PG8_SCHED
}
}

#define ATTN_STORE16(p,v) (*(u32x4*)(p)=(v))
namespace attn_body {
using bf16=__hip_bfloat16;
using bf16x8=__attribute__((ext_vector_type(8)))short;
using s16x4=__attribute__((ext_vector_type(4)))short;
using f32x16=__attribute__((ext_vector_type(16)))float;
using u32x4=__attribute__((ext_vector_type(4)))unsigned;
constexpr int NW=8,QBLK=32,QB=QBLK*NW,KVBLK=64;
__device__ __forceinline__ int crow(int r,int hi){return (r&3)+8*(r>>2)+4*hi;}
#define SBAR() __builtin_amdgcn_sched_barrier(0)
__device__ __forceinline__ void cmask(f32x16&p0,f32x16&p1,int jb,int qrel,int hi){
  const float NEG=-INFINITY; int kb=64*jb+4*hi;
  #pragma unroll
  for(int r=0;r<16;++r){int kv=kb+(r&3)+8*(r>>2); if(kv>qrel)p0[r]=NEG; if(kv+32>qrel)p1[r]=NEG;}
}

constexpr int NSLOT=3, SLOTB=8192;
constexpr int LDS_K=0, LDS_V=NSLOT*SLOTB, LDS_WS=2*NSLOT*SLOTB, LDS_OST=LDS_WS+NW*64*4, LDS_BYTES=LDS_OST+NW*4096;
constexpr float C2=0.125f*1.4426950408889634f;
__device__ __forceinline__ void glds16(const void*gsrc,unsigned lds_dst){unsigned keep;
  asm volatile("s_mov_b32 %0, m0\n\ts_mov_b32 m0, %2\n\ts_nop 0\n\tglobal_load_lds_dwordx4 %1, off\n\ts_mov_b32 m0, %0":"=&s"(keep):"v"(gsrc),"s"(lds_dst):"memory");}
__device__ __forceinline__ float max3f(float a,float b,float c){float r;asm("v_max3_f32 %0, %1, %2, %3":"=v"(r):"v"(a),"v"(b),"v"(c));return r;}
__device__ __forceinline__ float max2f(float a,float b){float r;asm("v_max_f32_e32 %0, %1, %2":"=v"(r):"v"(a),"v"(b));return r;}
__device__ __forceinline__ float fadd_s(float a,float b){float r;asm("v_add_f32_e32 %0, %1, %2":"=v"(r):"v"(a),"v"(b));return r;}
__device__ __forceinline__ float fsub_s(float a,float b){float r;asm("v_sub_f32_e32 %0, %1, %2":"=v"(r):"v"(a),"v"(b));return r;}
typedef float f32x2_t __attribute__((ext_vector_type(2))); typedef __bf16 bf16x2_t __attribute__((ext_vector_type(2)));
__device__ __forceinline__ unsigned cvtpk_s(float lo,float hi){f32x2_t v={lo,hi};bf16x2_t b=__builtin_convertvector(v,bf16x2_t);return __builtin_bit_cast(unsigned,b);}
#define WAIT_BAR(N) asm volatile("s_waitcnt vmcnt(" #N ") lgkmcnt(0)\n\ts_barrier":::"memory")

__device__ __forceinline__ void qkt(f32x16&p0,f32x16&p1,const char*Kslot,const bf16x8*qr,const f32x16&negm,int r32,int hi){
  const char*kb=Kslot+hi*1024+r32*16;
  #pragma unroll
  for(int d0=0;d0<4;++d0){
    const bf16x8 b0=*reinterpret_cast<const bf16x8*>(kb+d0*2048);
    const bf16x8 b1=*reinterpret_cast<const bf16x8*>(kb+d0*2048+512);
    if(d0==0){p0=__builtin_amdgcn_mfma_f32_32x32x16_bf16(b0,qr[0],negm,0,0,0);p1=__builtin_amdgcn_mfma_f32_32x32x16_bf16(b1,qr[0],negm,0,0,0);}
    else{p0=__builtin_amdgcn_mfma_f32_32x32x16_bf16(b0,qr[d0],p0,0,0,0);p1=__builtin_amdgcn_mfma_f32_32x32x16_bf16(b1,qr[d0],p1,0,0,0);}}
}
typedef __attribute__((address_space(3))) const char* lds_cptr;
typedef short v4i16_t __attribute__((ext_vector_type(4)));
__device__ __forceinline__ void kload8(bf16x8*kf,lds_cptr kp){
  kf[0]=*(const __attribute__((address_space(3))) bf16x8*)(kp);      kf[1]=*(const __attribute__((address_space(3))) bf16x8*)(kp+512);
  kf[2]=*(const __attribute__((address_space(3))) bf16x8*)(kp+2048); kf[3]=*(const __attribute__((address_space(3))) bf16x8*)(kp+2560);
  kf[4]=*(const __attribute__((address_space(3))) bf16x8*)(kp+4096); kf[5]=*(const __attribute__((address_space(3))) bf16x8*)(kp+4608);
  kf[6]=*(const __attribute__((address_space(3))) bf16x8*)(kp+6144); kf[7]=*(const __attribute__((address_space(3))) bf16x8*)(kp+6656);
}
__device__ __forceinline__ void kload2(bf16x8*kf,lds_cptr kp,int j){ kf[2*j]=*(const __attribute__((address_space(3))) bf16x8*)(kp+j*2048); kf[2*j+1]=*(const __attribute__((address_space(3))) bf16x8*)(kp+j*2048+512); }
__device__ __forceinline__ s16x4 vtr(lds_cptr p){ return __builtin_bit_cast(s16x4,__builtin_amdgcn_ds_read_tr16_b64_v4i16((__attribute__((address_space(3))) v4i16_t*)p)); }
__device__ __forceinline__ float rowmax(const f32x16&p0,const f32x16&p1){
  float a=max3f(p0[0],p0[1],p1[0]),b=max3f(p0[2],p0[3],p1[1]);a=max3f(a,p1[2],p1[3]);
  #pragma unroll
  for(int r=4;r<16;r+=4){a=max3f(a,p0[r],p0[r+1]);b=max3f(b,p0[r+2],p0[r+3]);a=max3f(a,p1[r],p1[r+1]);b=max3f(b,p1[r+2],p1[r+3]);}
  const float m=max2f(a,b);
  auto rr=__builtin_amdgcn_permlane32_swap(__float_as_uint(m),__float_as_uint(m),false,false);
  return max2f(__uint_as_float(rr[0]),__uint_as_float(rr[1]));
}
__device__ __forceinline__ void pv(f32x16*o,int vb,bf16x8 pa0,bf16x8 pa1,bf16x8 pa2,bf16x8 pa3){
  #pragma unroll
  for(int d0=0;d0<2;++d0){s16x4 lo[4],hi[4];
    #pragma unroll
    for(int ks=0;ks<4;++ks){
      asm volatile("ds_read_b64_tr_b16 %0,%1 offset:%c2":"=&v"(lo[ks]):"v"(vb),"i"(d0*4096+ks*1024):"memory");
      asm volatile("ds_read_b64_tr_b16 %0,%1 offset:%c2":"=&v"(hi[ks]):"v"(vb),"i"(d0*4096+ks*1024+512):"memory");}
    asm volatile("s_waitcnt lgkmcnt(0)":::"memory");SBAR();
    #define PK(k) (bf16x8){lo[k][0],lo[k][1],lo[k][2],lo[k][3],hi[k][0],hi[k][1],hi[k][2],hi[k][3]}
    o[d0]=__builtin_amdgcn_mfma_f32_32x32x16_bf16(pa0,PK(0),o[d0],0,0,0);
    o[d0]=__builtin_amdgcn_mfma_f32_32x32x16_bf16(pa1,PK(1),o[d0],0,0,0);
    o[d0]=__builtin_amdgcn_mfma_f32_32x32x16_bf16(pa2,PK(2),o[d0],0,0,0);
    o[d0]=__builtin_amdgcn_mfma_f32_32x32x16_bf16(pa3,PK(3),o[d0],0,0,0);
    #undef PK
  }
}

constexpr int PITCH=2560, OPITCH=1792, LDS_RPB=LDS_BYTES;
struct AUnit { const bf16*q; const bf16*k; const bf16*v; bf16*o; float*lse; const float*rpb; int qs,ks,NT,p0,p1,roff; };
template<int MODE> __device__ __forceinline__ void amask(f32x16&p0,f32x16&p1,int t,const AUnit&U,int wid,int r32,int hi,const float*rpbL){
  const float NEG=-INFINITY;
  if constexpr(MODE==2){
    const int base=64*t+4*hi-(U.p0+wid*32+r32);
    SBAR();
    #pragma unroll
    for(int r=0;r<16;++r){const int rel=base+(r&3)+8*(r>>2); if((unsigned)(rel+64)>128u)p0[r]=NEG; if((unsigned)(rel+96)>128u)p1[r]=NEG; if((r&3)==3)SBAR();}
  } else if constexpr(MODE==1){
    int r32l=r32; asm volatile("":"+v"(r32l));
    const int rq=U.p0+(wid>>1), cq=32*(wid&1)+r32l; const int r0=min(max(rq-4,0),56), c0=min(max(cq-8,0),48); const int kr=U.p1+t; int c0l=c0;
    { const bool rowok=(unsigned)(kr-r0)<8u; if(!rowok)c0l=1000;
      const float*bt=rpbL+(kr-rq+7)*31+(15-cq);
      #pragma unroll
      for(int r=0;r<16;r+=4){
        #pragma unroll
        for(int q=0;q<4;++q){const int kc=4*hi+((r+q)&3)+8*((r+q)>>2); const float b0=bt[kc]; p0[r+q]=((unsigned)(kc-c0l)<16u)?p0[r+q]+b0:NEG;}
        asm volatile("":"+v"(p0[r]),"+v"(p0[r+1]),"+v"(p0[r+2]),"+v"(p0[r+3]));
      }
      #pragma unroll
      for(int r=0;r<16;r+=4){
        #pragma unroll
        for(int q=0;q<4;++q){const int kc=32+4*hi+((r+q)&3)+8*((r+q)>>2); const float b1=bt[kc]; p1[r+q]=((unsigned)(kc-c0l)<16u)?p1[r+q]+b1:NEG;}
        asm volatile("":"+v"(p1[r]),"+v"(p1[r+1]),"+v"(p1[r+2]),"+v"(p1[r+3]));
      }
    }
  }
}
template<int THRL,int MODE> __device__ __forceinline__ void attn_unit(const AUnit&U,char*shm,int tid_in){
  const int tid=tid_in,lane=tid&63,r32=lane&31,hi=lane>>5; const int wid=__builtin_amdgcn_readfirstlane(tid>>6);
  const long qstep=(long)U.qs*PITCH, kstep_=(long)U.ks*PITCH; float*rpbL=(float*)(shm+LDS_RPB)+(MODE==1?U.roff:0);
  const bf16*Qw=U.q+(long)(wid*QBLK)*qstep;
  const bf16*Kh=U.k,*Vh=U.v;
  const unsigned lds0=(unsigned)(uintptr_t)shm;
  float*wsf=(float*)(shm+LDS_WS)+wid*64;
  const bf16*ksrc=Kh+(long)lane*kstep_+wid*8;
  const bf16*vsrc=Vh+(long)(16*(wid&3)+(lane>>2))*kstep_+(wid>>2)*32+(lane&3)*8;
  const unsigned kdst=lds0+LDS_K+wid*1024, vdst=lds0+LDS_V+wid*1024;
  #define DMA_K(t,slot) glds16(ksrc+(long)(t)*KVBLK*kstep_,(unsigned)__builtin_amdgcn_readfirstlane(kdst+(slot)))
  #define DMA_V(t,slot) glds16(vsrc+(long)(t)*KVBLK*kstep_,(unsigned)__builtin_amdgcn_readfirstlane(vdst+(slot)))
  const int vb0=(int)(lds0+LDS_V)+((lane>>4)&1)*32+(lane&3)*8+(4*hi+((lane&15)>>2))*64;
  const char*Kbase=shm+LDS_K; bf16x8 kf[8];
  const lds_cptr shm3=(lds_cptr)shm; const lds_cptr kp0=shm3+LDS_K+hi*1024+r32*16; const lds_cptr vp0=shm3+LDS_V+((lane>>4)&1)*32+(lane&3)*8+(4*hi+((lane&15)>>2))*64;
  const int NT=U.NT;
  DMA_K(0,0);DMA_V(0,0);DMA_K(1,SLOTB);
  bf16x8 qr[4];
  #pragma unroll
  for(int d0=0;d0<4;++d0)qr[d0]=*reinterpret_cast<const bf16x8*>(&Qw[(long)r32*qstep+d0*16+hi*8]);
  float mhat=0.f,l_reg=0.f;f32x16 o[2];f32x16 negm; { float z_=0.f; asm volatile("":"+v"(z_)); _Pragma("unroll") for(int r=0;r<16;++r){o[0][r]=z_;o[1][r]=z_;negm[r]=z_;} } if constexpr(MODE!=1){asm volatile("":"+v"(negm));}
  const int qrel=wid*QBLK+r32;
  #define CMASK(P0,P1,t) amask<MODE>(P0,P1,(t),U,wid,r32,hi,rpbL)
  bool resc=false;
  #define START(P0,P1) do{ const float rm=rowmax(P0,P1); resc=false; \
    { const float dl=__builtin_fmaxf(rm,-30.f); mhat=fadd_s(mhat,dl); \
      _Pragma("unroll") for(int r=0;r<16;++r){P0[r]=fsub_s(P0[r],dl);P1[r]=fsub_s(P1[r],dl);} \
      if constexpr(MODE!=1){ _Pragma("unroll") for(int r=0;r<16;++r)negm[r]=-mhat; asm volatile("":"+v"(negm)); } } \
    _Pragma("unroll") for(int r=0;r<16;++r)P0[r]=__builtin_amdgcn_exp2f(P0[r]); }while(0)
  #define RESC() do{ if(resc){ asm volatile("s_waitcnt lgkmcnt(0)":::"memory"); \
      _Pragma("unroll") for(int d_=0;d_<2;++d_) _Pragma("unroll") for(int r=0;r<16;++r)o[d_][r]*=wsf[crow(r,hi)]; } }while(0)
  f32x16 pA0,pA1,pB0,pB1;
  int sl_prev=0,sl_cur=0,sl_next=SLOTB;
  #define ROT() do{sl_prev=sl_cur;sl_cur=sl_next;sl_next=(sl_next==(NSLOT-1)*SLOTB)?0:sl_next+SLOTB;}while(0)
  DMA_K(2,2*SLOTB);
  if constexpr(MODE==1){ if(U.rpb){ for(int i_=tid;i_<465;i_+=512) rpbL[i_]=U.rpb[i_]*1.4426950408889634f; } }
  WAIT_BAR(3);
  qkt(pA0,pA1,Kbase,qr,negm,r32,hi);asm volatile("s_nop 15\n\ts_nop 7":"+v"(pA0),"+v"(pA1));CMASK(pA0,pA1,0);
  START(pA0,pA1);
  _Pragma("unroll") for(int r=0;r<16;++r)pA1[r]=__builtin_amdgcn_exp2f(pA1[r]);
  WAIT_BAR(0);
  DMA_K(3,0);DMA_V(1,SLOTB);
  ROT();
  kload8(kf,kp0+sl_cur);
  WAIT_BAR(2);
  s16x4 vlo[8],vhi[8]; u32x4 pw0,pw1,pw2,pw3;
  #define PKW(P,B) cvtpk_s(P[B],P[B+1])
  #define PAF(k) __builtin_bit_cast(bf16x8,pw##k)
  #define VFR(i) (bf16x8){vlo[i][0],vlo[i][1],vlo[i][2],vlo[i][3],vhi[i][0],vhi[i][1],vhi[i][2],vhi[i][3]}
  #define PIN(x) asm volatile("":"+v"(x))
  #define MX3(a,b,c) __builtin_fmaxf(__builtin_fmaxf((a),(b)),(c))
  #define GAPA(MF,A0,A1,A2,A3,W0,W1,PW) do{ MF; sacc+=A0; sacc+=A1; sacc+=A2; sacc+=A3; PIN(sacc); W0; W1; PIN(PW); SBAR(); }while(0)
  #define EX(v) __builtin_amdgcn_exp2f(v)
  #define GAPB(MF,X,B) do{ MF; X[B]=EX(X[B]); X[B+1]=EX(X[B+1]); X[B+2]=EX(X[B+2]); X[B+3]=EX(X[B+3]); PIN(X); SBAR(); }while(0)
  #define VRD(i) do{ vlo[i]=vtr(vp_+(((i)>>2)*4096+((i)&3)*1024)); vhi[i]=vtr(vp_+(((i)>>2)*4096+((i)&3)*1024+512)); }while(0)
  #define KRD(G,j) do{ if(G){ kload2(kf,kp0+sl_next,j); SBAR(); } }while(0)
  #define STEP(C0,C1,P0,P1,t,GK,GV,GL) do{ SBAR(); \
    const lds_cptr vp_=vp0+sl_prev; \
    VRD(0); SBAR(); float sacc=(P0[0]+P0[1]); \
    if constexpr(MODE==1){ const float nm_=-mhat; _Pragma("unroll") for(int r=0;r<16;++r){C0[r]=nm_;C1[r]=nm_;} } \
    GAPA(C0=__builtin_amdgcn_mfma_f32_32x32x16_bf16(kf[0],qr[0],(MODE==1?C0:negm),0,0,0), P0[2],P0[3],P0[4],P0[5],     pw0[0]=PKW(P0,0), pw0[1]=PKW(P0,2), pw0); \
    VRD(4); SBAR(); GAPA(C1=__builtin_amdgcn_mfma_f32_32x32x16_bf16(kf[1],qr[0],(MODE==1?C1:negm),0,0,0), P0[6],P0[7],P0[8],P0[9],     pw0[2]=PKW(P0,4), pw0[3]=PKW(P0,6), pw0); \
    VRD(1); SBAR(); GAPA(C0=__builtin_amdgcn_mfma_f32_32x32x16_bf16(kf[2],qr[1],C0,0,0,0),   P0[10],P0[11],P0[12],P0[13], pw1[0]=PKW(P0,8), pw1[1]=PKW(P0,10), pw1); \
    VRD(5); SBAR(); GAPA(C1=__builtin_amdgcn_mfma_f32_32x32x16_bf16(kf[3],qr[1],C1,0,0,0),   P0[14],P0[15],P1[0],P1[1],   pw1[2]=PKW(P0,12),pw1[3]=PKW(P0,14), pw1); \
    VRD(2); SBAR(); GAPA(C0=__builtin_amdgcn_mfma_f32_32x32x16_bf16(kf[4],qr[2],C0,0,0,0),   P1[2],P1[3],P1[4],P1[5],     pw2[0]=PKW(P1,0), pw2[1]=PKW(P1,2), pw2); \
    VRD(6); SBAR(); GAPA(C1=__builtin_amdgcn_mfma_f32_32x32x16_bf16(kf[5],qr[2],C1,0,0,0),   P1[6],P1[7],P1[8],P1[9],     pw2[2]=PKW(P1,4), pw2[3]=PKW(P1,6), pw2); \
    VRD(3); SBAR(); GAPA(C0=__builtin_amdgcn_mfma_f32_32x32x16_bf16(kf[6],qr[3],C0,0,0,0),   P1[10],P1[11],P1[12],P1[13], pw3[0]=PKW(P1,8), pw3[1]=PKW(P1,10), pw3); \
    VRD(7); SBAR(); GAPA(C1=__builtin_amdgcn_mfma_f32_32x32x16_bf16(kf[7],qr[3],C1,0,0,0),   P1[14],P1[15],0.f,0.f,       pw3[2]=PKW(P1,12),pw3[3]=PKW(P1,14), pw3); \
    l_reg+=sacc; \
    if(GK){DMA_K((t)+3,sl_cur);} if(GV){DMA_V((t)+1,sl_next);} \
    CMASK(C0,C1,t); \
    { float a=MX3(C0[0],C0[1],C1[0]),b=MX3(C0[2],C0[3],C1[1]); a=MX3(a,C1[2],C1[3]); \
      _Pragma("unroll") for(int r=4;r<16;r+=4){a=MX3(a,C0[r],C0[r+1]);b=MX3(b,C0[r+2],C0[r+3]);a=MX3(a,C1[r],C1[r+1]);b=MX3(b,C1[r+2],C1[r+3]);} \
      float rm=__builtin_fmaxf(a,b); { auto rr=__builtin_amdgcn_permlane32_swap(__float_as_uint(rm),__float_as_uint(rm),false,false); rm=__builtin_fmaxf(__uint_as_float(rr[0]),__uint_as_float(rr[1])); } \
      resc=false; \
      if(__builtin_expect(__any(rm>(float)THRL),0)){ const float dl=__builtin_fmaxf(rm,0.f); mhat+=dl; \
        _Pragma("unroll") for(int r=0;r<16;++r){C0[r]-=dl;C1[r]-=dl;} \
        if constexpr(MODE!=1){ _Pragma("unroll") for(int r=0;r<16;++r)negm[r]=-mhat; asm volatile("":"+v"(negm)); } \
        const float f=__builtin_amdgcn_exp2f(-dl); l_reg*=f; if(hi==0)wsf[r32]=f; resc=true; } } \
    SBAR(); \
    GAPB(o[0]=__builtin_amdgcn_mfma_f32_32x32x16_bf16(PAF(0),VFR(0),o[0],0,0,0), C0,0); \
    GAPB(o[1]=__builtin_amdgcn_mfma_f32_32x32x16_bf16(PAF(0),VFR(4),o[1],0,0,0), C0,4); \
    KRD(GL,0); GAPB(o[0]=__builtin_amdgcn_mfma_f32_32x32x16_bf16(PAF(1),VFR(1),o[0],0,0,0), C0,8); \
    KRD(GL,1); GAPB(o[1]=__builtin_amdgcn_mfma_f32_32x32x16_bf16(PAF(1),VFR(5),o[1],0,0,0), C0,12); \
    KRD(GL,2); GAPB(o[0]=__builtin_amdgcn_mfma_f32_32x32x16_bf16(PAF(2),VFR(2),o[0],0,0,0), C1,0); \
    KRD(GL,3); GAPB(o[1]=__builtin_amdgcn_mfma_f32_32x32x16_bf16(PAF(2),VFR(6),o[1],0,0,0), C1,4); \
    GAPB(o[0]=__builtin_amdgcn_mfma_f32_32x32x16_bf16(PAF(3),VFR(3),o[0],0,0,0), C1,8); \
    GAPB(o[1]=__builtin_amdgcn_mfma_f32_32x32x16_bf16(PAF(3),VFR(7),o[1],0,0,0), C1,12); \
    }while(0)
  int t=1;
  for(;t+5<NT;t+=2){
    STEP(pB0,pB1,pA0,pA1,t,true,true,true);     WAIT_BAR(2); RESC(); ROT();
    STEP(pA0,pA1,pB0,pB1,t+1,true,true,true);   WAIT_BAR(2); RESC(); ROT();
  }
  #define ENDW(tt) do{ if((tt)+3<NT){WAIT_BAR(2);} else if((tt)+2<NT){WAIT_BAR(1);} else {WAIT_BAR(0);} }while(0)
  for(;t+1<NT;t+=2){
    STEP(pB0,pB1,pA0,pA1,t,(t+3<NT),(t+1<NT),(t+1<NT));       ENDW(t);   RESC(); ROT();
    STEP(pA0,pA1,pB0,pB1,t+1,(t+4<NT),(t+2<NT),(t+2<NT));     ENDW(t+1); RESC(); ROT();
  }
  STEP(pB0,pB1,pA0,pA1,NT-1,false,false,false); RESC();
  { float sacc=pB0[0]+pB0[1]; _Pragma("unroll") for(int r=2;r<16;++r)sacc+=pB0[r]; _Pragma("unroll") for(int r=0;r<16;++r)sacc+=pB1[r]; l_reg+=sacc;
    pw0=(u32x4){PKW(pB0,0),PKW(pB0,2),PKW(pB0,4),PKW(pB0,6)};pw1=(u32x4){PKW(pB0,8),PKW(pB0,10),PKW(pB0,12),PKW(pB0,14)};pw2=(u32x4){PKW(pB1,0),PKW(pB1,2),PKW(pB1,4),PKW(pB1,6)};pw3=(u32x4){PKW(pB1,8),PKW(pB1,10),PKW(pB1,12),PKW(pB1,14)};
    SBAR(); pv(o,vb0+sl_cur,PAF(0),PAF(1),PAF(2),PAF(3)); }
  #undef PKW
  #undef PAF
  #undef VFR
  #undef PIN
  #undef MX3
  #undef GAPA
  #undef GAPB
  #undef EX
  #undef VRD
  #undef KRD
  #undef STEP
  #undef ENDW
  int lane_e=lane; asm volatile("":"+v"(lane_e)); const int r32e=lane_e&31, hie=lane_e>>5;
  {auto rr=__builtin_amdgcn_permlane32_swap(__float_as_uint(l_reg),__float_as_uint(l_reg),false,false);l_reg=__uint_as_float(rr[0])+__uint_as_float(rr[1]);}
  if(hie==0)wsf[32+r32e]=l_reg;asm volatile("s_waitcnt lgkmcnt(0)":::"memory");
  float rli[16];
  #pragma unroll
  for(int r=0;r<16;++r)rli[r]=__builtin_amdgcn_rcpf(wsf[32+crow(r,hie)]);
  bf16*Ow=U.o+(long)(wid*QBLK)*U.qs*OPITCH; if(U.lse&&hie==0)U.lse[(long)(wid*QBLK+r32e)*U.qs*6]=mhat+__builtin_log2f(l_reg);
  { bf16*stg=(bf16*)(shm+LDS_OST)+wid*2048;
    #pragma unroll
    for(int r=0;r<16;++r){const int orow=crow(r,hie);
      #pragma unroll
      for(int d0=0;d0<2;++d0)stg[orow*64+d0*32+r32e]=__float2bfloat16(o[d0][r]*rli[r]);}
    asm volatile("s_waitcnt lgkmcnt(0)":::"memory");
    #pragma unroll
    for(int i=0;i<4;++i){const int row=i*8+(lane_e>>3),ch=lane_e&7; const u32x4 v=*(const u32x4*)(stg+row*64+ch*8); ATTN_STORE16(Ow+(long)row*U.qs*OPITCH+ch*8,v);} }
  asm volatile("s_waitcnt lgkmcnt(0)\n\ts_barrier":::"memory");
  #undef DMA_K
  #undef DMA_V
  #undef CMASK
  #undef START
  #undef RESC
  #undef ROT
}
template<int MODE> __device__ __forceinline__ void attn_unit_simple(const AUnit&U,char*shm,int tid_in){
  const int tid=tid_in,lane=tid&63,r32=lane&31,hi=lane>>5; const int wid=__builtin_amdgcn_readfirstlane(tid>>6);
  const long qstep=(long)U.qs*PITCH, kstep_=(long)U.ks*PITCH; float*rpbL=(float*)(shm+LDS_RPB);
  const bf16*Qw=U.q+(long)(wid*QBLK)*qstep;
  const unsigned lds0=(unsigned)(uintptr_t)shm;
  float*wsf=(float*)(shm+LDS_WS)+wid*64;
  const bf16*ksrc=U.k+(long)lane*kstep_+wid*8;
  const bf16*vsrc=U.v+(long)(16*(wid&3)+(lane>>2))*kstep_+(wid>>2)*32+(lane&3)*8;
  const unsigned kdst=lds0+LDS_K+wid*1024, vdst=lds0+LDS_V+wid*1024;
  const int vb0=(int)(lds0+LDS_V)+((lane>>4)&1)*32+(lane&3)*8+(4*hi+((lane&15)>>2))*64;
  const char*Kbase=shm+LDS_K;
  const int NT=U.NT;
  bf16x8 qr[4];
  #pragma unroll
  for(int d0=0;d0<4;++d0)qr[d0]=*reinterpret_cast<const bf16x8*>(&Qw[(long)r32*qstep+d0*16+hi*8]);
  if constexpr(MODE==1){ for(int i_=tid;i_<465;i_+=512) rpbL[i_]=U.rpb[i_]*1.4426950408889634f; }
  glds16(ksrc,(unsigned)__builtin_amdgcn_readfirstlane(kdst)); glds16(vsrc,(unsigned)__builtin_amdgcn_readfirstlane(vdst));
  if(NT>1){ glds16(ksrc+(long)KVBLK*kstep_,(unsigned)__builtin_amdgcn_readfirstlane(kdst+SLOTB)); glds16(vsrc+(long)KVBLK*kstep_,(unsigned)__builtin_amdgcn_readfirstlane(vdst+SLOTB)); }
  float mhat=-30.f,l_reg=0.f; f32x16 o[2]; f32x16 zc;
  { float z_=0.f; asm volatile("":"+v"(z_)); _Pragma("unroll") for(int r=0;r<16;++r){o[0][r]=z_;o[1][r]=z_;zc[r]=z_;} }
  int sl=0, sl2=2*SLOTB;
  for(int t=0;t<NT;++t){
    if(t+1<NT){ asm volatile("s_waitcnt vmcnt(2) lgkmcnt(0)\n\ts_barrier":::"memory"); } else { asm volatile("s_waitcnt vmcnt(0) lgkmcnt(0)\n\ts_barrier":::"memory"); }
    if(t+2<NT){ glds16(ksrc+(long)(t+2)*KVBLK*kstep_,(unsigned)__builtin_amdgcn_readfirstlane(kdst+sl2)); glds16(vsrc+(long)(t+2)*KVBLK*kstep_,(unsigned)__builtin_amdgcn_readfirstlane(vdst+sl2)); }
    f32x16 p0,p1; qkt(p0,p1,Kbase+sl,qr,zc,r32,hi); asm volatile("s_nop 15\n\ts_nop 7":"+v"(p0),"+v"(p1));
    amask<MODE>(p0,p1,t,U,wid,r32,hi,rpbL);
    const float rm=rowmax(p0,p1); const float mnew=__builtin_fmaxf(mhat,rm); const float f=__builtin_amdgcn_exp2f(mhat-mnew); mhat=mnew; l_reg*=f;
    if(hi==0)wsf[r32]=f; asm volatile("s_waitcnt lgkmcnt(0)":::"memory");
    #pragma unroll
    for(int d_=0;d_<2;++d_)
      #pragma unroll
      for(int r=0;r<16;++r)o[d_][r]*=wsf[crow(r,hi)];
    float sacc=0.f;
    #pragma unroll
    for(int r=0;r<16;++r){p0[r]=__builtin_amdgcn_exp2f(p0[r]-mnew);p1[r]=__builtin_amdgcn_exp2f(p1[r]-mnew);sacc+=p0[r]+p1[r];}
    l_reg+=sacc;
    #define PKW(P,B) cvtpk_s(P[B],P[B+1])
    const u32x4 pw0=(u32x4){PKW(p0,0),PKW(p0,2),PKW(p0,4),PKW(p0,6)},pw1=(u32x4){PKW(p0,8),PKW(p0,10),PKW(p0,12),PKW(p0,14)},pw2=(u32x4){PKW(p1,0),PKW(p1,2),PKW(p1,4),PKW(p1,6)},pw3=(u32x4){PKW(p1,8),PKW(p1,10),PKW(p1,12),PKW(p1,14)};
    #undef PKW
    asm volatile("s_waitcnt lgkmcnt(0)":::"memory");
    pv(o,vb0+sl,__builtin_bit_cast(bf16x8,pw0),__builtin_bit_cast(bf16x8,pw1),__builtin_bit_cast(bf16x8,pw2),__builtin_bit_cast(bf16x8,pw3));
    sl=(sl==2*SLOTB)?0:sl+SLOTB; sl2=(sl2==2*SLOTB)?0:sl2+SLOTB;
  }
  asm volatile("s_waitcnt lgkmcnt(0)\n\ts_barrier":::"memory");
  {auto rr=__builtin_amdgcn_permlane32_swap(__float_as_uint(l_reg),__float_as_uint(l_reg),false,false);l_reg=__uint_as_float(rr[0])+__uint_as_float(rr[1]);}
  if(hi==0)wsf[32+r32]=l_reg;asm volatile("s_waitcnt lgkmcnt(0)":::"memory");
  float rli[16];
  #pragma unroll
  for(int r=0;r<16;++r)rli[r]=__builtin_amdgcn_rcpf(wsf[32+crow(r,hi)]);
  bf16*Ow=U.o+(long)(wid*QBLK)*U.qs*OPITCH; if(U.lse&&hi==0)U.lse[(long)(wid*QBLK+r32)*U.qs*6]=mhat+__builtin_log2f(l_reg);
  { bf16*stg=(bf16*)(shm+LDS_OST)+wid*2048;
    #pragma unroll
    for(int r=0;r<16;++r){const int orow=crow(r,hi);
      #pragma unroll
      for(int d0=0;d0<2;++d0)stg[orow*64+d0*32+r32]=__float2bfloat16(o[d0][r]*rli[r]);}
    asm volatile("s_waitcnt lgkmcnt(0)":::"memory");
    #pragma unroll
    for(int i=0;i<4;++i){const int row=i*8+(lane>>3),ch=lane&7; const u32x4 v=*(const u32x4*)(stg+row*64+ch*8); ATTN_STORE16(Ow+(long)row*U.qs*OPITCH+ch*8,v);} }
  asm volatile("s_waitcnt lgkmcnt(0)\n\ts_barrier":::"memory");
}
template<int MODE> __device__ __forceinline__ void attn_wave(const AUnit&U,char*shm,int wid,int lane,float*wsf,const float*rpbL,int kbyte,int vbyte){
  const int r32=lane&31,hi=lane>>5;
  const long qstep=(long)U.qs*PITCH, kstep_=(long)U.ks*PITCH;
  const bf16*Qw=U.q+(long)(wid*QBLK)*qstep;
  int t0,t1;
  if constexpr(MODE==2){ const int lo_=U.p0+32*wid-64, hi_=U.p0+32*wid+95; t0=lo_<0?0:(lo_>>6); t1=hi_>>6; if(t1>U.NT-1)t1=U.NT-1; }
  else { const int rq=U.p0+(wid>>1); const int r0=min(max(rq-4,0),56); t0=r0-U.p1; t1=t0+7; }
  const unsigned lds0=(unsigned)(uintptr_t)shm;
  const bf16*ksrc=U.k+(long)lane*kstep_;
  const bf16*vsrc=U.v+(long)(lane>>2)*kstep_+(lane&3)*8;
  const int vb0=(int)(lds0+vbyte)+((lane>>4)&1)*32+(lane&3)*8+(4*hi+((lane&15)>>2))*64;
  bf16x8 qr[4];
  #pragma unroll
  for(int d0=0;d0<4;++d0)qr[d0]=*reinterpret_cast<const bf16x8*>(&Qw[(long)r32*qstep+d0*16+hi*8]);
  float mhat=-30.f,l_reg=0.f; f32x16 o[2]; f32x16 zc;
  { float z_=0.f; asm volatile("":"+v"(z_)); _Pragma("unroll") for(int r=0;r<16;++r){o[0][r]=z_;o[1][r]=z_;zc[r]=z_;} }
  for(int t=t0;t<=t1;++t){
    asm volatile("s_waitcnt lgkmcnt(0)":::"memory");
    const bf16*kt=ksrc+(long)t*KVBLK*kstep_; const bf16*vt=vsrc+(long)t*KVBLK*kstep_;
    #pragma unroll
    for(int c=0;c<8;++c) glds16(kt+c*8,(unsigned)__builtin_amdgcn_readfirstlane(lds0+kbyte+c*1024));
    #pragma unroll
    for(int p=0;p<8;++p) glds16(vt+(long)(16*(p&3))*kstep_+(p>>2)*32,(unsigned)__builtin_amdgcn_readfirstlane(lds0+vbyte+p*1024));
    asm volatile("s_waitcnt vmcnt(8)":::"memory");
    f32x16 p0,p1; qkt(p0,p1,shm+kbyte,qr,zc,r32,hi); asm volatile("s_nop 15\n\ts_nop 7":"+v"(p0),"+v"(p1));
    amask<MODE>(p0,p1,t,U,wid,r32,hi,rpbL);
    const float rm=rowmax(p0,p1); const float mnew=__builtin_fmaxf(mhat,rm); const float f=__builtin_amdgcn_exp2f(mhat-mnew); mhat=mnew; l_reg*=f;
    if(hi==0)wsf[r32]=f; asm volatile("s_waitcnt lgkmcnt(0)":::"memory");
    #pragma unroll
    for(int d_=0;d_<2;++d_)
      #pragma unroll
      for(int r=0;r<16;++r)o[d_][r]*=wsf[crow(r,hi)];
    float sacc=0.f;
    #pragma unroll
    for(int r=0;r<16;++r){p0[r]=__builtin_amdgcn_exp2f(p0[r]-mnew);p1[r]=__builtin_amdgcn_exp2f(p1[r]-mnew);sacc+=p0[r]+p1[r];}
    l_reg+=sacc;
    #define PKW(P,B) cvtpk_s(P[B],P[B+1])
    const u32x4 pw0=(u32x4){PKW(p0,0),PKW(p0,2),PKW(p0,4),PKW(p0,6)},pw1=(u32x4){PKW(p0,8),PKW(p0,10),PKW(p0,12),PKW(p0,14)},pw2=(u32x4){PKW(p1,0),PKW(p1,2),PKW(p1,4),PKW(p1,6)},pw3=(u32x4){PKW(p1,8),PKW(p1,10),PKW(p1,12),PKW(p1,14)};
    #undef PKW
    asm volatile("s_waitcnt vmcnt(0) lgkmcnt(0)":::"memory");
    pv(o,vb0,__builtin_bit_cast(bf16x8,pw0),__builtin_bit_cast(bf16x8,pw1),__builtin_bit_cast(bf16x8,pw2),__builtin_bit_cast(bf16x8,pw3));
  }
  asm volatile("s_waitcnt lgkmcnt(0)":::"memory");
  {auto rr=__builtin_amdgcn_permlane32_swap(__float_as_uint(l_reg),__float_as_uint(l_reg),false,false);l_reg=__uint_as_float(rr[0])+__uint_as_float(rr[1]);}
  if(hi==0)wsf[32+r32]=l_reg;asm volatile("s_waitcnt lgkmcnt(0)":::"memory");
  float rli[16];
  #pragma unroll
  for(int r=0;r<16;++r)rli[r]=__builtin_amdgcn_rcpf(wsf[32+crow(r,hi)]);
  bf16*Ow=U.o+(long)(wid*QBLK)*U.qs*OPITCH; if(U.lse&&hi==0)U.lse[(long)(wid*QBLK+r32)*U.qs*6]=mhat+__builtin_log2f(l_reg);
  { bf16*stg=(bf16*)(shm+kbyte);
    #pragma unroll
    for(int r=0;r<16;++r){const int orow=crow(r,hi);
      #pragma unroll
      for(int d0=0;d0<2;++d0)stg[orow*64+d0*32+r32]=__float2bfloat16(o[d0][r]*rli[r]);}
    asm volatile("s_waitcnt lgkmcnt(0)":::"memory");
    #pragma unroll
    for(int i=0;i<4;++i){const int row=i*8+(lane>>3),ch=lane&7; const u32x4 v=*(const u32x4*)(stg+row*64+ch*8); ATTN_STORE16(Ow+(long)row*U.qs*OPITCH+ch*8,v);} }
  asm volatile("s_waitcnt lgkmcnt(0)":::"memory");
}
#undef SBAR
#undef WAIT_BAR
}
namespace cg = cooperative_groups;
#define GAS __attribute__((address_space(1)))
#define LAS __attribute__((address_space(3)))
typedef unsigned v4u __attribute__((ext_vector_type(4)));
typedef float f32x4 __attribute__((ext_vector_type(4)));
constexpr int NWAVES = 8;
constexpr int RING_BYTES = 131072, HALO_OFF = RING_BYTES, XBST_OFF = RING_BYTES + 4096, LDS_TOTAL = RING_BYTES + 4096 + 64;
constexpr size_t WL_IN = 0, WL_OUT = 5 * MiB, WL_GU = 7 * MiB, WL_DN = 18 * MiB, WL_STRIDE = 24 * MiB;
static_assert(attn_body::LDS_RPB + 465 * 4 <= RING_BYTES, "attention scratch fits the ring region");

__device__ __forceinline__ unsigned pk2(float lo, float hi) { return pg8::cvt_pk_bf16(lo, hi); }
__device__ __forceinline__ int dmap_in(int oc) {
    const int hd = oc >> 6, c = oc & 63, pn = hd >> 2, wc = hd & 3; int bj, pos;
    const bool partial = (hd >= 12 && hd < 24), axial = (hd >= 30 && hd < 38);
    if (partial) { if (c < 8) { bj = 0; pos = c; } else if (c < 16) { bj = 1; pos = c - 8; } else if (c < 40) { bj = 0; pos = c - 8; } else { bj = 1; pos = c - 32; } }
    else if (axial) { if (c < 16) { bj = 0; pos = c; } else if (c < 32) { bj = 1; pos = c - 16; } else if (c < 48) { bj = 0; pos = c - 16; } else { bj = 1; pos = c - 32; } }
    else { bj = c >> 5; pos = c & 31; }
    return pn * 256 + bj * 128 + wc * 32 + pos;
}
__device__ __forceinline__ int dmap_gu(int oc) { const int bj = oc >= DFF ? 1 : 0, ch = oc - bj * DFF; return (ch >> 7) * 256 + bj * 128 + (ch & 127); }
template <int MAP> __device__ __forceinline__ void p0_item(const float* W, const float* gk, int K, int N, bf16_t* WT, LAS float* scr, int item, int lane) {
    const int nblk = N / 32, kb = item / nblk, nb = item % nblk, k0 = 64 * kb, n0 = 32 * nb;
    {
        float4 wv[8];
#pragma unroll
        for (int i = 0; i < 8; ++i) wv[i] = *(const float4*)(W + (size_t)(k0 + 8 * i + (lane >> 3)) * N + n0 + (lane & 7) * 4);
#pragma unroll
        for (int i = 0; i < 8; ++i) { const int kk = 8 * i + (lane >> 3); const float g_ = gk ? gk[k0 + kk] : 1.f; LAS float* d = scr + kk * 33 + (lane & 7) * 4;
            d[0] = wv[i].x * g_; d[1] = wv[i].y * g_; d[2] = wv[i].z * g_; d[3] = wv[i].w * g_; }
    }
    asm volatile("s_waitcnt lgkmcnt(0)" ::: "memory");
    const int c = lane & 7;
#pragma unroll
    for (int j = 0; j < 4; ++j) { const int n = (lane >> 3) + 8 * j; const LAS float* s = scr + (8 * c) * 33 + n;
        v4u o; o.x = pk2(s[0 * 33], s[1 * 33]); o.y = pk2(s[2 * 33], s[3 * 33]); o.z = pk2(s[4 * 33], s[5 * 33]); o.w = pk2(s[6 * 33], s[7 * 33]);
        const int oc = n0 + n, dr = MAP == 1 ? dmap_in(oc) : MAP == 2 ? dmap_gu(oc) : oc;
        *(v4u*)(WT + (size_t)dr * K + k0 + 8 * c) = o; }
    asm volatile("s_waitcnt lgkmcnt(0)" ::: "memory");
}
template <int CTRL> __device__ __forceinline__ float dppf(float v) { return __uint_as_float((unsigned)__builtin_amdgcn_update_dpp(0, (int)__float_as_uint(v), CTRL, 0xf, 0xf, false)); }
__device__ __forceinline__ float wave_sum2(float v) {
    v += dppf<0xB1>(v); v += dppf<0x4E>(v); v += dppf<0x141>(v); v += dppf<0x140>(v);
    return pg8::quad_row_sum(v);
}
__device__ __forceinline__ void prep_row(const float* xrow, bf16_t* xbrow, float* ssprow, int lane) {
    const float4* xr = (const float4*)xrow; float ss = 0.f;
#pragma unroll
    for (int j = 0; j < 4; ++j) { const float4 v = xr[lane + 64 * j]; ss += (v.x * v.x + v.y * v.y) + (v.z * v.z + v.w * v.w);
        uint2 o; o.x = pk2(v.x, v.y); o.y = pk2(v.z, v.w); *(uint2*)(xbrow + (lane + 64 * j) * 4) = o; }
    ss = wave_sum2(ss);
    if (lane < 16) ssprow[lane] = lane == 0 ? ss : 0.f;
}
__device__ __forceinline__ void unpack8(const uint4 v, float (&f)[8]) {
    f[0] = __uint_as_float(v.x << 16); f[1] = __uint_as_float(v.x & 0xffff0000u); f[2] = __uint_as_float(v.y << 16); f[3] = __uint_as_float(v.y & 0xffff0000u);
    f[4] = __uint_as_float(v.z << 16); f[5] = __uint_as_float(v.z & 0xffff0000u); f[6] = __uint_as_float(v.w << 16); f[7] = __uint_as_float(v.w & 0xffff0000u);
}
__device__ __forceinline__ void mixfin_row(const bf16_t* ob, const float* lse, int row, const float* og, bf16_t* mo, int lane) {
    const int c8 = lane * 8, hd = lane >> 3; const bool a_on = lane < 32, s_on = lane < 48;
    const uint4 z4 = make_uint4(0u, 0u, 0u, 0u);
    const uint4 ua = a_on ? *(const uint4*)(ob + c8) : z4;
    const uint4 u0 = s_on ? *(const uint4*)(ob + 256 + c8) : z4, u1 = s_on ? *(const uint4*)(ob + 1024 + c8) : z4, u2 = s_on ? *(const uint4*)(ob + 1408 + c8) : z4, uc = s_on ? *(const uint4*)(ob + 640 + c8) : z4;
    const float l0 = s_on ? lse[((size_t)0 * M + row) * 6 + hd] : 0.f, l1 = s_on ? lse[((size_t)1 * M + row) * 6 + hd] : 0.f, l2 = s_on ? lse[((size_t)2 * M + row) * 6 + hd] : 0.f;
    float ga[8], gd[8], gc[8];
    { const float4 t0 = a_on ? *(const float4*)(og + c8) : make_float4(0, 0, 0, 0), t1 = a_on ? *(const float4*)(og + c8 + 4) : make_float4(0, 0, 0, 0);
      ga[0] = t0.x; ga[1] = t0.y; ga[2] = t0.z; ga[3] = t0.w; ga[4] = t1.x; ga[5] = t1.y; ga[6] = t1.z; ga[7] = t1.w; }
    { const float4 t0 = s_on ? *(const float4*)(og + 256 + c8) : make_float4(0, 0, 0, 0), t1 = s_on ? *(const float4*)(og + 256 + c8 + 4) : make_float4(0, 0, 0, 0);
      gd[0] = t0.x; gd[1] = t0.y; gd[2] = t0.z; gd[3] = t0.w; gd[4] = t1.x; gd[5] = t1.y; gd[6] = t1.z; gd[7] = t1.w; }
    { const float4 t0 = s_on ? *(const float4*)(og + 640 + c8) : make_float4(0, 0, 0, 0), t1 = s_on ? *(const float4*)(og + 640 + c8 + 4) : make_float4(0, 0, 0, 0);
      gc[0] = t0.x; gc[1] = t0.y; gc[2] = t0.z; gc[3] = t0.w; gc[4] = t1.x; gc[5] = t1.y; gc[6] = t1.z; gc[7] = t1.w; }
    float fa[8], f0[8], f1[8], f2[8], fc[8];
    unpack8(ua, fa); unpack8(u0, f0); unpack8(u1, f1); unpack8(u2, f2); unpack8(uc, fc);
    const float mx = fmaxf(l0, fmaxf(l1, l2)); const float w0 = exp2f(l0 - mx), w1 = exp2f(l1 - mx), w2 = exp2f(l2 - mx); const float iw = 1.f / (w0 + w1 + w2);
    float sa = 0.f, sd = 0.f, sc = 0.f;
#pragma unroll
    for (int i = 0; i < 8; ++i) { f0[i] = (w0 * f0[i] + w1 * f1[i] + w2 * f2[i]) * iw; sa += fa[i] * fa[i]; sd += f0[i] * f0[i]; sc += fc[i] * fc[i]; }
    sa = wave_sum2(sa); sd = wave_sum2(sd); sc = wave_sum2(sc);
    const float ra = rsqrtf(sa * (1.f / 256.f) + EPS), rd = rsqrtf(sd * (1.f / 384.f) + EPS), rc = rsqrtf(sc * (1.f / 384.f) + EPS);
    if (a_on) { uint4 o; o.x = pk2(fa[0] * ra * ga[0], fa[1] * ra * ga[1]); o.y = pk2(fa[2] * ra * ga[2], fa[3] * ra * ga[3]); o.z = pk2(fa[4] * ra * ga[4], fa[5] * ra * ga[5]); o.w = pk2(fa[6] * ra * ga[6], fa[7] * ra * ga[7]); *(uint4*)(mo + c8) = o; }
    if (s_on) { uint4 o; o.x = pk2(f0[0] * rd * gd[0], f0[1] * rd * gd[1]); o.y = pk2(f0[2] * rd * gd[2], f0[3] * rd * gd[3]); o.z = pk2(f0[4] * rd * gd[4], f0[5] * rd * gd[5]); o.w = pk2(f0[6] * rd * gd[6], f0[7] * rd * gd[7]); *(uint4*)(mo + 256 + c8) = o;
                uint4 p; p.x = pk2(fc[0] * rc * gc[0], fc[1] * rc * gc[1]); p.y = pk2(fc[2] * rc * gc[2], fc[3] * rc * gc[3]); p.z = pk2(fc[4] * rc * gc[4], fc[5] * rc * gc[5]); p.w = pk2(fc[6] * rc * gc[6], fc[7] * rc * gc[7]); *(uint4*)(mo + 640 + c8) = p; }
}
#define RLX_AGENT __ATOMIC_RELAXED, __HIP_MEMORY_SCOPE_AGENT
#define XB_TMO      128
#define XB_XCNT(j)  (256  + 64 * (j))
#define XB_XSUB(j)  (1280 + 64 * (j))
#define XB_XGEN(j)  (2304 + 64 * (j))
#define XB_TOP      3328
#define XB_TOPGEN   3392
#define XCD_BAR_WORDS 3456
#define XB_SPIN_CAP (1u << 18)

__device__ __forceinline__ unsigned xb_ld(unsigned* p)              { return __hip_atomic_load(p, __ATOMIC_RELAXED, __HIP_MEMORY_SCOPE_AGENT); }
__device__ __forceinline__ unsigned xb_add(unsigned* p, unsigned v) { return __hip_atomic_fetch_add(p, v, __ATOMIC_RELAXED, __HIP_MEMORY_SCOPE_AGENT); }
__device__ __forceinline__ unsigned xb_xcc_id() { return (unsigned)__builtin_amdgcn_s_getreg((3 << 11) | 20) & 0xFu; }
#define XB_SPIN(cond, bar) do { unsigned _sp = 0; while (cond) { __builtin_amdgcn_s_sleep(1); \
    if ((++_sp & 255u) == 0u) { if (xb_ld(&(bar)[XB_TMO])) break; if (_sp > XB_SPIN_CAP) { atomicAdd(&(bar)[XB_TMO], 1u); break; } } } } while (0)

struct XcdBarrier {
    unsigned* bar; unsigned x;
    volatile LAS unsigned* st;
};

__device__ __forceinline__ XcdBarrier xcd_barrier_post(unsigned* bar, volatile LAS unsigned* st) {
    XcdBarrier b; b.bar = bar; b.x = xb_xcc_id(); b.st = st;
    if (threadIdx.x == 0) (void)xb_add(&bar[XB_XCNT(b.x)], 1u);
    return b;
}
__device__ __forceinline__ void xcd_barrier_complete(unsigned* bar, unsigned x, unsigned& nloc, unsigned& nx) {
    const unsigned G = gridDim.x * gridDim.y * gridDim.z;
    unsigned sum, cnt, mine, sp = 0u;
    for (;;) {
        sum = 0u; cnt = 0u; mine = 0u;
#pragma unroll
        for (unsigned j = 0; j < 16; ++j) { const unsigned c = xb_ld(&bar[XB_XCNT(j)]); sum += c; cnt += (c > 0u) ? 1u : 0u; mine = (j == x) ? c : mine; }
        if (sum == G) break;
        __builtin_amdgcn_s_sleep(1);
        if ((++sp & 255u) == 0u) { if (xb_ld(&bar[XB_TMO])) break; if (sp > XB_SPIN_CAP) { atomicAdd(&bar[XB_TMO], 1u); break; } }
    }
    nloc = mine > 0u ? mine : 1u; nx = cnt > 0u ? cnt : 1u;
}

__device__ __forceinline__ void xcd_barrier(const XcdBarrier& b, int tid_b) {
    asm volatile("s_waitcnt vmcnt(0)" ::: "memory");
    __syncthreads();
    if (tid_b == 0) {
        unsigned* bar = b.bar;
        __builtin_amdgcn_s_waitcnt(0);
        unsigned nloc = b.st[0], nx = b.st[1];
        if (nloc == 0u) { xcd_barrier_complete(bar, b.x, nloc, nx); b.st[0] = nloc; b.st[1] = nx; }
        const unsigned old = xb_add(&bar[XB_XSUB(b.x)], 1u);
        const unsigned gen = old / nloc;
        if (old + 1u == (gen + 1u) * nloc) {
            __builtin_amdgcn_fence(__ATOMIC_RELEASE, "agent");
            asm volatile("s_waitcnt vmcnt(0)" ::: "memory");
            const unsigned og = xb_add(&bar[XB_TOP], 1u);
            const unsigned tg = og / nx;
            if (og + 1u == (tg + 1u) * nx) xb_add(&bar[XB_TOPGEN], 1u);
            else XB_SPIN(xb_ld(&bar[XB_TOPGEN]) == tg, bar);
            __builtin_amdgcn_fence(__ATOMIC_ACQUIRE, "agent");
            xb_add(&bar[XB_XGEN(b.x)], 1u);
            asm volatile("s_waitcnt vmcnt(0)" ::: "memory");
        } else {
            XB_SPIN(xb_ld(&bar[XB_XGEN(b.x)]) == gen, bar);
            __builtin_amdgcn_fence(__ATOMIC_ACQUIRE, "agent");
            asm volatile("s_waitcnt vmcnt(0)" ::: "memory");
        }
    }
    __syncthreads();
}

#ifndef NMAJ_P1
#define NMAJ_P1 0
#endif
#ifndef NMAJ_P5
#define NMAJ_P5 0
#endif
#ifndef WGM_P1
#define WGM_P1 2
#endif
#ifndef WGM_RES
#define WGM_RES 2
#endif
#ifndef WGM_P5
#define WGM_P5 2
#endif
#ifndef ALIGN_P1
#define ALIGN_P1 true
#endif
#ifndef ALIGN_RES
#define ALIGN_RES true
#endif
#ifndef THRL_GQA
#define THRL_GQA 8
#endif
#ifndef REP_P1
#define REP_P1 1
#endif
#ifndef REP_GQA
#define REP_GQA 1
#endif
#ifndef REP_NA
#define REP_NA 1
#endif
#ifndef REP_DIL
#define REP_DIL 1
#endif
#ifndef REP_P3
#define REP_P3 1
#endif
#ifndef REP_P5
#define REP_P5 1
#endif
#ifndef CHEAP_P5
#define CHEAP_P5 0
#endif
#ifndef REP_SYNC
#define REP_SYNC 1
#endif
struct Args { const float* in[13]; float* out; unsigned char* ws; int ph_lo, ph_hi; };
__device__ __forceinline__ int phase_tid(int wave_s) {
    unsigned ones = ~0u; asm volatile("" : "+s"(ones));
    const int lane = (int)__builtin_amdgcn_mbcnt_hi(ones, __builtin_amdgcn_mbcnt_lo(ones, 0u));
    return wave_s * 64 + lane;
}
typedef __attribute__((address_space(4))) const Args* cargs_t;
__device__ __forceinline__ cargs_t launder_args() { cargs_t p = (cargs_t)__builtin_amdgcn_kernarg_segment_ptr(); asm volatile("" : "+s"(p)); return p; }
#ifndef FWD_ALIGN
#define FWD_ALIGN 256
#endif
__global__ void __launch_bounds__(NWAVES * 64, 2) __attribute__((aligned(FWD_ALIGN))) fwd(Args args) {
    extern __shared__ __attribute__((aligned(16))) unsigned char lds[];
    cg::grid_group grid = cg::this_grid();
    const int G = gridDim.x, bx = blockIdx.x, vcu = (G % 8 == 0) ? (bx % 8) * (G / 8) + bx / 8 : bx;
#define GIN(i) ((const float*)(GAS const float*)AP->in[i])
#define PHASE_ARGS cargs_t AP = launder_args(); unsigned char* ws = (unsigned char*)(GAS unsigned char*)AP->ws; float* out = (float*)(GAS float*)AP->out; const float* x = GIN(0); (void)out; (void)x; \
    f32x2v_t* rot1 = (f32x2v_t*)(ws + WS_TAB); f32x2v_t* rotax = rot1 + 4096 * 8; (void)rotax; float* ssp = (float*)(ws + WS_SSP); float* lse = (float*)(ws + WS_LSE); (void)ssp; (void)lse; \
    bf16_t* XB = (bf16_t*)(ws + WS_XB); bf16_t* PROJ = (bf16_t*)(ws + WS_PROJ); bf16_t* OBUF = (bf16_t*)(ws + WS_OBUF); bf16_t* MIX = (bf16_t*)(ws + WS_MIX); bf16_t* ACT = (bf16_t*)(ws + WS_ACT); \
    (void)XB; (void)PROJ; (void)OBUF; (void)MIX; (void)ACT; unsigned char* wb = ws + WS_W + l * WL_STRIDE; (void)wb; \
    const int tid = phase_tid(wave_s), lane = tid & 63, wave = __builtin_amdgcn_readfirstlane(tid >> 6), gw = vcu * NWAVES + wave; (void)lane; (void)gw;
    const int lo = args.ph_lo, hi = args.ph_hi;
    if (threadIdx.x < 16) ((LAS unsigned*)((LAS unsigned char*)lds + XBST_OFF))[threadIdx.x] = 0u;
    int wave_s = __builtin_amdgcn_readfirstlane((int)(threadIdx.x >> 6)); asm volatile("" : "+s"(wave_s));
    __syncthreads();
    if (lo == 0 && hi > 2 && blockIdx.x == 0) { cargs_t AP0 = launder_args(); unsigned* bw = (unsigned*)((GAS unsigned char*)AP0->ws + WS_CTL); for (int i = threadIdx.x; i < XCD_BAR_WORDS; i += NWAVES * 64) bw[i] = 0u; }
#define IN(k) (lo <= (k) && (k) < hi)
#define SEAM(k) do { if (IN(k) && IN((k) + 1)) { for (int rs_ = 0; rs_ < REP_SYNC; ++rs_) { if ((k) == 0) { grid.sync(); cargs_t APc = launder_args(); (void)xcd_barrier_post((unsigned*)((GAS unsigned char*)APc->ws + WS_CTL), (volatile LAS unsigned*)((LAS unsigned char*)lds + XBST_OFF)); } else { cargs_t AP_ = launder_args(); XcdBarrier xb_; xb_.bar = (unsigned*)((GAS unsigned char*)AP_->ws + WS_CTL); xb_.x = xb_xcc_id(); xb_.st = (volatile LAS unsigned*)((LAS unsigned char*)lds + XBST_OFF); xcd_barrier(xb_, phase_tid(wave_s)); } } } } while (0)
    const int NGW = G * NWAVES;
    if (IN(0)) { const int l = 0; PHASE_ARGS
        LAS float* scr = (LAS float*)((LAS unsigned char*)lds + wave * 16384);
        constexpr int I_IN = 16 * 80, I_OUT = 16 * 32, I_GU = 16 * 176, I_DN = 44 * 32, I_L = I_IN + I_OUT + I_GU + I_DN;
        for (int it = gw; it < 2 * I_L; it += NGW) {
            const int l = it / I_L; int r = it % I_L; unsigned char* wb2 = ws + WS_W + l * WL_STRIDE;
            if (r < I_IN) { p0_item<1>(GIN(2) + (size_t)l * DM * DIN, GIN(1) + l * DM, DM, DIN, (bf16_t*)(wb2 + WL_IN), scr, r, lane); continue; } r -= I_IN;
            if (r < I_OUT) { p0_item<0>(GIN(7) + (size_t)l * DM * DM, nullptr, DM, DM, (bf16_t*)(wb2 + WL_OUT), scr, r, lane); continue; } r -= I_OUT;
            if (r < I_GU) { p0_item<2>(GIN(9) + (size_t)l * DM * 2 * DFF, GIN(8) + l * DM, DM, 2 * DFF, (bf16_t*)(wb2 + WL_GU), scr, r, lane); continue; } r -= I_GU;
            p0_item<0>(GIN(12) + (size_t)l * DFF * DM, nullptr, DFF, DM, (bf16_t*)(wb2 + WL_DN), scr, r, lane);
        }
        for (int i = bx * 512 + tid; i < 4096 * 8; i += G * 512) { const float2 cs = sincos_d((double)(i >> 3) * INV1[i & 7]); rot1[i] = (f32x2v_t){cs.x, cs.y}; }
        for (int i = bx * 512 + tid; i < 64 * 16; i += G * 512) { const float2 cs = sincos_d((double)(i >> 4) * INV2[i & 15]); rotax[i] = (f32x2v_t){cs.x, cs.y}; }
        for (int m = gw; m < M; m += 2 * NGW) { prep_row(x + (size_t)m * DM, XB + (size_t)m * DM, ssp + (size_t)m * 16, lane); prep_row(x + (size_t)(m + NGW) * DM, XB + (size_t)(m + NGW) * DM, ssp + (size_t)(m + NGW) * 16, lane); }
        __syncthreads();
    }
    SEAM(0);
    for (int l = 0; l < 2; ++l) {
        const int pb = 1 + 6 * l;
#ifndef SKIP_P1
        if (IN(pb)) { PHASE_ARGS
            pg8::Gemm g{XB, (const bf16_t*)(wb + WL_IN), M, DIN, DM, 256, 0}; pg8::StaticOrder S; S.init(M, DIN, G, bx);
            pg8::EpiIn E{PROJ, ssp, GIN(3) + l * 192, GIN(4) + l * 192, (const pg8::f32x2v*)rot1, (const pg8::f32x2v*)rotax};
            for (int rep = 0; rep < REP_P1; ++rep) pg8::gemm_phase<pg8::EpiIn, pg8::StaticOrder, ALIGN_P1, true>((LAS unsigned char*)lds, g, S, E, tid);
        }
#endif
        SEAM(pb);
#ifndef SKIP_P2
        if (IN(pb + 1)) { PHASE_ARGS
            using namespace attn_body;
            const bf16* P = (const bf16*)PROJ; bf16* O = (bf16*)OBUF;
#ifndef SKIP_GQA
            const int tid_GQA = phase_tid(wave_s);
            for (int rep = 0; rep < REP_GQA; ++rep) for (int id = vcu; id < 768; id += G) {
                const int qb = id & 15, g3 = (id >> 4) % 3, bk = id / 48, b = bk >> 1, kvh = bk & 1, h = kvh * 3 + g3;
                AUnit U; U.q = P + ((size_t)b * SEQ + 256 * qb) * PITCH + 1920 + h * 64; U.k = P + (size_t)b * SEQ * PITCH + 2304 + kvh * 64; U.v = P + (size_t)b * SEQ * PITCH + 2432 + kvh * 64;
                U.o = O + ((size_t)b * SEQ + 256 * qb) * OPITCH + 640 + h * 64; U.lse = nullptr; U.rpb = nullptr; U.qs = 1; U.ks = 1; U.NT = 64; U.p0 = 0; U.p1 = 0; U.roff = 0;
                attn_unit<THRL_GQA, 0>(U, (char*)lds, tid_GQA);
            }
#endif
#ifndef SKIP_NA
            const int tid_NA = phase_tid(wave_s);
            { __syncthreads(); float* rp4 = (float*)((char*)lds + attn_body::LDS_RPB); const float* rg = GIN(5) + l * 4 * 465; for (int i = tid_NA; i < 4 * 465; i += 512) rp4[i] = rg[i] * LOG2E; __syncthreads(); }
            for (int rep = 0; rep < REP_NA; ++rep) for (int id = vcu; id < 512; id += G) {
                const int u4 = id & 15, h = (id >> 4) & 3, b = id >> 6, R = 4 * u4; const int kr0 = min(max(R - 4, 0), 56), last = min(max(R - 1, 0), 56) + 7; int nt = last - kr0 + 1; nt += nt & 1;
                AUnit U; U.q = P + ((size_t)b * SEQ + 256 * u4) * PITCH + h * 64; U.k = P + ((size_t)b * SEQ + 64 * kr0) * PITCH + 256 + h * 64; U.v = P + ((size_t)b * SEQ + 64 * kr0) * PITCH + 512 + h * 64;
                U.o = O + ((size_t)b * SEQ + 256 * u4) * OPITCH + h * 64; U.lse = nullptr; U.rpb = nullptr; U.roff = h * 465; U.qs = 1; U.ks = 1; U.NT = nt; U.p0 = R; U.p1 = kr0;
                attn_unit<8, 1>(U, (char*)lds, phase_tid(wave_s));
            }
#endif
#ifndef SKIP_DIL
            const int tid_DIL = phase_tid(wave_s);
            for (int rep = 0; rep < REP_DIL; ++rep) for (int id = vcu; id < 2304; id += G) {
                int pat, rem; if (id < 768) { pat = 0; rem = id; } else if (id < 1536) { pat = 1; rem = id - 768; } else { pat = 2; rem = id - 1536; }
                const int d = pat == 0 ? 1 : pat == 1 ? 4 : 16, L = SEQ / d, nqb = L / 256;
                const int sub = rem & 15, bh = rem >> 4, h = bh % 6, b = bh / 6; const int res = sub / nqb, qb = sub % nqb;
                int kt0, nt; if (L == 256) { kt0 = 0; nt = 4; } else { kt0 = min(max(4 * qb - 1, 0), L / 64 - 6); nt = 6; }
                const size_t qtok = (size_t)b * SEQ + res + (size_t)d * 256 * qb, ktok = (size_t)b * SEQ + res + (size_t)d * 64 * kt0;
                AUnit U; U.q = P + qtok * PITCH + 768 + h * 64; U.k = P + ktok * PITCH + 1152 + h * 64; U.v = P + ktok * PITCH + 1536 + h * 64;
                U.o = O + qtok * OPITCH + (pat == 0 ? 256 : pat == 1 ? 1024 : 1408) + h * 64; U.lse = lse + ((size_t)pat * M + qtok) * 6 + h; U.rpb = nullptr; U.roff = 0; U.qs = d; U.ks = d; U.NT = nt; U.p0 = 256 * qb - 64 * kt0; U.p1 = 0;
                attn_unit<8, 2>(U, (char*)lds, tid_DIL);
            }
#endif
        }
#endif
        SEAM(pb + 1);
        if (IN(pb + 2)) { PHASE_ARGS for (int rep = 0; rep < REP_P3; ++rep) for (int m = gw; m < M; m += 2 * NGW) { mixfin_row(OBUF + (size_t)m * OB_LD, lse, m, GIN(6) + l * DM, MIX + (size_t)m * DM, lane); mixfin_row(OBUF + (size_t)(m + NGW) * OB_LD, lse, m + NGW, GIN(6) + l * DM, MIX + (size_t)(m + NGW) * DM, lane); } __syncthreads(); }
        SEAM(pb + 2);
#ifndef SKIP_P4
        if (IN(pb + 3)) { PHASE_ARGS
            pg8::Gemm g{MIX, (const bf16_t*)(wb + WL_OUT), M, DM, DM, 256, 0}; pg8::StaticOrder S; S.init(M, DM, G, bx);
            pg8::EpiRes E{l == 0 ? x : out, out, XB, ssp};
            pg8::gemm_phase<pg8::EpiRes, pg8::StaticOrder, ALIGN_RES, true>((LAS unsigned char*)lds, g, S, E, tid);
        }
#endif
        SEAM(pb + 3);
#ifndef SKIP_P5
        if (IN(pb + 4)) { PHASE_ARGS
            pg8::Gemm g{XB, (const bf16_t*)(wb + WL_GU), M, 2 * DFF, DM, 254, -1}; pg8::StaticOrder S; S.init2(130, 22, G, bx);
            pg8::EpiGateConv E{ACT, ssp, GIN(10) + l * 3 * DFF, GIN(11) + l * DFF, (LAS float*)((LAS unsigned char*)lds + HALO_OFF), 0};
            for (int rep = 0; rep < REP_P5; ++rep) { E.cheap = (rep + 1 < REP_P5) ? CHEAP_P5 : 0; pg8::gemm_phase<pg8::EpiGateConv, pg8::StaticOrder, true, true>((LAS unsigned char*)lds, g, S, E, tid); }
        }
#endif
        SEAM(pb + 4);
#ifndef SKIP_P6
        if (IN(pb + 5)) { PHASE_ARGS
            pg8::Gemm g{ACT, (const bf16_t*)(wb + WL_DN), M, DM, DFF, 256, 0}; pg8::StaticOrder S; S.init(M, DM, G, bx);
            pg8::EpiRes E{out, out, l == 0 ? XB : nullptr, l == 0 ? ssp : nullptr};
            pg8::gemm_phase<pg8::EpiRes, pg8::StaticOrder, ALIGN_RES, true>((LAS unsigned char*)lds, g, S, E, tid);
        }
#endif
        if (l == 0) SEAM(pb + 5);
    }
#undef IN
#undef SEAM
}


#ifndef DBG_FAST
#define DBG_FAST -1
#endif
extern "C" void kernel_launch(void* const* d_in, const int* in_sizes, int n_in, void* d_out, int out_size, void* d_ws, size_t ws_size, hipStream_t stream) {
    static int grid = 0;
    if (grid == 0) {
        int dev = 0, cus = 0, per_cu = 0;
        (void)hipGetDevice(&dev); (void)hipDeviceGetAttribute(&cus, hipDeviceAttributeMultiprocessorCount, dev);
        (void)hipFuncSetAttribute((const void*)fwd, hipFuncAttributeMaxDynamicSharedMemorySize, LDS_TOTAL);
        (void)hipOccupancyMaxActiveBlocksPerMultiprocessor(&per_cu, (const void*)fwd, NWAVES * 64, LDS_TOTAL);
        if (per_cu < 1) { fprintf(stderr, "kernel_launch: occupancy query says %d blocks per CU\n", per_cu); per_cu = 1; }
        grid = cus * 1;
    }
#if DBG_FAST >= 0
    (void)hipMemsetAsync((char*)d_ws + WS_CTL, 0, 16384, stream);
#endif
    Args a{};
    for (int i = 0; i < 13; ++i) a.in[i] = (const float*)d_in[i];
    a.out = (float*)d_out; a.ws = (unsigned char*)d_ws;
#if DBG_FAST < 0
    a.ph_lo = 0; a.ph_hi = 13;
    void* kargs[] = {&a};
    hipError_t e = hipLaunchCooperativeKernel((const void*)fwd, dim3(grid), dim3(NWAVES * 64), kargs, LDS_TOTAL, stream);
    if (e != hipSuccess) fprintf(stderr, "cooperative launch failed: %s (grid %d)\n", hipGetErrorString(e), grid);
#else
    const float* x = (const float*)d_in[0]; const float* n1 = (const float*)d_in[1]; const float* w_in = (const float*)d_in[2]; const float* qg = (const float*)d_in[3];
    const float* kg = (const float*)d_in[4]; const float* rpb = (const float*)d_in[5]; const float* og = (const float*)d_in[6]; const float* w_out = (const float*)d_in[7];
    const float* n2 = (const float*)d_in[8]; const float* w_gu = (const float*)d_in[9]; const float* cw = (const float*)d_in[10]; const float* cb = (const float*)d_in[11];
    const float* w_dn = (const float*)d_in[12];
    unsigned char* ws = (unsigned char*)d_ws; float* out = (float*)d_out;
    float2* rot1 = (float2*)(ws + WS_TAB); float2* rotax = rot1 + 4096 * 8;
    float* ssp = (float*)(ws + WS_SSP); float* lse = (float*)(ws + WS_LSE);
    bf16_t* XB = (bf16_t*)(ws + WS_XB); bf16_t* PROJ = (bf16_t*)(ws + WS_PROJ); bf16_t* OBUF = (bf16_t*)(ws + WS_OBUF); bf16_t* MIX = (bf16_t*)(ws + WS_MIX); bf16_t* ACT = (bf16_t*)(ws + WS_ACT);
    float* TMP = (float*)(ws + WS_TMP);
    auto phase = [&](int p) { a.ph_lo = p; a.ph_hi = p + 1; hipLaunchKernelGGL(fwd, dim3(grid), dim3(NWAVES * 64), LDS_TOTAL, stream, a); };
    const int F = DBG_FAST;
    if (F & 1) phase(0); else { k_tables<<<128, 256, 0, stream>>>(rot1, rotax); k_prep_x<<<M / 4, 256, 0, stream>>>(x, XB, ssp); }
    for (int l = 0; l < 2; ++l) {
        const float* src = l == 0 ? x : out; const int pb = 1 + 6 * l;
        if (F & 2) phase(pb); else for (int b = 0; b < BATCH; ++b) {
            k_ngemm<0><<<dim3(DIN / 64, SEQ / 64), 256, 0, stream>>>(XB + (size_t)b * SEQ * DM, DM, n1 + l * DM, w_in + (size_t)l * DM * DIN, DIN, DM, ssp + (size_t)b * SEQ * 16, TMP, DIN, nullptr);
            k_qkfix<<<SEQ * 40 / 256, 256, 0, stream>>>(TMP, b * SEQ, PROJ, qg + l * 192, kg + l * 192, rot1, rotax);
        }
        if (F & 4) phase(pb + 1); else {
            k_nattn<0><<<dim3(M / 256, 4), 256, 0, stream>>>(PROJ, OBUF, lse, rpb + l * 4 * 15 * 31, 0);
            for (int p = 0; p < 3; ++p) k_nattn<1><<<dim3(M / 256, 6), 256, 0, stream>>>(PROJ, OBUF, lse, nullptr, p);
            k_nattn<2><<<dim3(M / 256, 6), 256, 0, stream>>>(PROJ, OBUF, lse, nullptr, 0);
        }
        if (F & 8) phase(pb + 2); else k_mixfin<<<M / 4, 256, 0, stream>>>(OBUF, lse, og + l * DM, MIX);
        if (F & 16) phase(pb + 3); else {
            k_ngemm<1><<<dim3(DM / 64, M / 64), 256, 0, stream>>>(MIX, DM, nullptr, w_out + (size_t)l * DM * DM, DM, DM, nullptr, out, DM, src);
            k_prep_x<<<M / 4, 256, 0, stream>>>(out, XB, ssp);
        }
        if (F & 32) phase(pb + 4); else for (int b = 0; b < BATCH; ++b) {
            k_ngemm<0><<<dim3(2 * DFF / 64, SEQ / 64), 256, 0, stream>>>(XB + (size_t)b * SEQ * DM, DM, n2 + l * DM, w_gu + (size_t)l * DM * 2 * DFF, 2 * DFF, DM, ssp + (size_t)b * SEQ * 16, TMP, 2 * DFF, nullptr);
            k_conv<<<SEQ * DFF / 256, 256, 0, stream>>>(TMP, b * SEQ, cw + l * 3 * DFF, cb + l * DFF, ACT);
        }
        if (F & 64) phase(pb + 5); else {
            k_ngemm<1><<<dim3(DM / 64, M / 64), 256, 0, stream>>>(ACT, DFF, nullptr, w_dn + (size_t)l * DFF * DM, DM, DFF, nullptr, out, DM, out);
            if (l == 0) k_prep_x<<<M / 4, 256, 0, stream>>>(out, XB, ssp);
        }
    }
#endif
}
```
